# Optimizing an MI355X kernel written in HIP

```python
import jax, jax.numpy as jnp
from jax import lax
import numpy as np

D_MODEL = 2048
BATCH = 8
SEQ = 2048
DEPTH = 2

CTX_LEN = 256
GRID_W = 64
D_MIX = D_MODEL
HEAD_DIM = 128
ATTN_W = D_MIX // 2
N_HEADS = ATTN_W // HEAD_DIM
N_KV_HEADS = 2
GQA_GROUP = N_HEADS // N_KV_HEADS
KV_W = N_KV_HEADS * HEAD_DIM
POOL_W = D_MIX // 4
POOL_WINDOWS = (2, 4, 8, 16)
POOL_GROUPS = len(POOL_WINDOWS)
POOL_GC = POOL_W // POOL_GROUPS
FOURIER_W = D_MIX - ATTN_W - POOL_W
FOURIER_GROUPS = 4
FOURIER_GC = FOURIER_W // FOURIER_GROUPS
OFF_Q = 0
OFF_K = OFF_Q + ATTN_W
OFF_V = OFF_K + KV_W
OFF_POOL = OFF_V + KV_W
OFF_FOURIER = OFF_POOL + POOL_W
OFF_GATE = OFF_FOURIER + FOURIER_W
IN_W = OFF_GATE + D_MIX
Q_BLOCK = 128
ROPE_THETA = 10000.0
AXIS_ROT = HEAD_DIM // 2
EPS = 1e-6

kernel_name = "hybrid_gqa_pool_fourier_prefix_dit"


def rmsnorm(x, g):
    xf = x.astype(jnp.float32)
    y = xf * lax.rsqrt(jnp.mean(xf * xf, axis=-1, keepdims=True) + EPS)
    return (y * g.astype(jnp.float32)).astype(x.dtype)


def axial_rope_tables(n):
    rows_count = n // GRID_W
    row = jnp.broadcast_to(jnp.arange(rows_count, dtype=jnp.float32)[:, None], (rows_count, GRID_W)).reshape(-1)
    col = jnp.broadcast_to(jnp.arange(GRID_W, dtype=jnp.float32)[None, :], (rows_count, GRID_W)).reshape(-1)
    inv = ROPE_THETA ** (-jnp.arange(0, AXIS_ROT, 2, dtype=jnp.float32) / AXIS_ROT)
    ang = jnp.stack([row[:, None] * inv, col[:, None] * inv], axis=1)
    return jnp.cos(ang), jnp.sin(ang)


def apply_axial_rope(x, cos, sin):
    B, N, H, _ = x.shape
    xr = x.astype(jnp.float32).reshape(B, N, H, 2, 2, AXIS_ROT // 2)
    x1, x2 = xr[..., 0, :], xr[..., 1, :]
    c = cos[None, :, None]
    s = sin[None, :, None]
    out = jnp.stack([x1 * c - x2 * s, x2 * c + x1 * s], axis=-2)
    return out.reshape(B, N, H, HEAD_DIM).astype(x.dtype)


def attend(qg, keys, vals):
    s = jnp.einsum('bqkgd,bskd->bkgqs', qg, keys, preferred_element_type=jnp.float32) * (HEAD_DIM ** -0.5)
    p = jax.nn.softmax(s, axis=-1).astype(vals.dtype)
    return jnp.einsum('bkgqs,bskd->bqkgd', p, vals)


def latent_attention(q, k, v, kc, vc):
    B, N = q.shape[:2]
    keys = jnp.concatenate([kc, k], axis=1)
    vals = jnp.concatenate([vc, v], axis=1)
    nb = N // Q_BLOCK
    qb = q.reshape(B, nb, Q_BLOCK, N_KV_HEADS, GQA_GROUP, HEAD_DIM).transpose(1, 0, 2, 3, 4, 5)
    o = lax.map(lambda qi: attend(qi, keys, vals), qb)
    return o.transpose(1, 0, 2, 3, 4, 5).reshape(B, N, ATTN_W)


def context_attention(qc, kc, vc):
    B, C = qc.shape[:2]
    qg = qc.reshape(B, C, N_KV_HEADS, GQA_GROUP, HEAD_DIM)
    return attend(qg, kc, vc).reshape(B, C, ATTN_W)


def multiscale_pool(u, pool_w, pool_scale):
    B, N, _ = u.shape
    uf = u.astype(jnp.float32).reshape(B, N, POOL_GROUPS, POOL_GC)
    cs = jnp.concatenate([jnp.zeros((B, 1, POOL_GROUPS, POOL_GC), jnp.float32), jnp.cumsum(uf, axis=1)], axis=1)
    t = jnp.arange(N, dtype=jnp.int32)
    outs = []
    for gi, win in enumerate(POOL_WINDOWS):
        lo = jnp.clip(t - win // 2, 0, N - 1)
        hi = jnp.clip(t + (win - win // 2) - 1, 0, N - 1)
        cnt = (hi - lo + 1).astype(jnp.float32)
        csg = cs[:, :, gi]
        win_sum = jnp.take(csg, hi + 1, axis=1) - jnp.take(csg, lo, axis=1)
        outs.append(win_sum / cnt[None, :, None] - uf[:, :, gi])
    pooled = jnp.stack(outs, axis=2).astype(u.dtype)
    y = jnp.einsum('bngc,gcd->bngd', pooled, pool_w).reshape(B, N, POOL_W)
    return y * pool_scale


def fourier_mix(u, fourier_w):
    B, N, _ = u.shape
    uf = u.astype(jnp.float32).reshape(B, N, FOURIER_GROUPS, FOURIER_GC)
    f = jnp.fft.fft2(uf, axes=(1, 3), norm='ortho').real.astype(u.dtype)
    return jnp.einsum('bngc,gcd->bngd', f, fourier_w).reshape(B, N, FOURIER_W)


def split_proj(p):
    return (p[..., OFF_Q:OFF_K], p[..., OFF_K:OFF_V], p[..., OFF_V:OFF_POOL],
            p[..., OFF_POOL:OFF_FOURIER], p[..., OFF_FOURIER:OFF_GATE], p[..., OFF_GATE:])


def merge_branches(att, u_pool, u_four, g, pool_w, pool_scale, fourier_w, w_out):
    mixed = jnp.concatenate([att, multiscale_pool(u_pool, pool_w, pool_scale), fourier_mix(u_four, fourier_w)], axis=-1)
    return (mixed * jax.nn.silu(g)) @ w_out


def setup_inputs(seed: int = 0) -> dict:
    key = jax.random.key(seed)
    ks = jax.random.split(key, 20)
    f32 = jnp.float32
    nrm = lambda k, shape: jax.random.normal(k, shape, f32)
    return {
        "x": nrm(ks[0], (BATCH, SEQ, D_MODEL)),
        "c": nrm(ks[1], (BATCH, D_MODEL)),
        "ctx": nrm(ks[2], (BATCH, CTX_LEN, D_MODEL)),
        "c_ctx": nrm(ks[3], (D_MODEL,)),
        "ada_w": nrm(ks[4], (DEPTH, D_MODEL, 3 * D_MODEL)) * (0.5 * D_MODEL ** -0.5),
        "ada_b": nrm(ks[5], (DEPTH, 3 * D_MODEL)) * 0.01,
        "norm_g": 1.0 + 0.02 * nrm(ks[6], (DEPTH, D_MODEL)),
        "w_in": nrm(ks[7], (DEPTH, D_MODEL, IN_W)) * (D_MODEL ** -0.5),
        "q_norm_g": 1.0 + 0.02 * nrm(ks[8], (DEPTH, HEAD_DIM)),
        "k_norm_g": 1.0 + 0.02 * nrm(ks[9], (DEPTH, HEAD_DIM)),
        "pool_w": nrm(ks[10], (DEPTH, POOL_GROUPS, POOL_GC, POOL_GC)) * (POOL_GC ** -0.5),
        "pool_scale": 1.0 + 0.02 * nrm(ks[11], (DEPTH, POOL_W)),
        "fourier_w": nrm(ks[12], (DEPTH, FOURIER_GROUPS, FOURIER_GC, FOURIER_GC)) * (FOURIER_GC ** -0.5),
        "w_out": nrm(ks[13], (DEPTH, D_MIX, D_MODEL)) * (D_MIX ** -0.5),
        "final_norm_g": 1.0 + 0.02 * nrm(ks[14], (D_MODEL,)),
    }


def reference(x, c, ctx, c_ctx, ada_w, ada_b, norm_g, w_in, q_norm_g, k_norm_g,
              pool_w, pool_scale, fourier_w, w_out, final_norm_g):
    B, N, _ = x.shape
    C = ctx.shape[1]
    cos, sin = axial_rope_tables(N)
    xc = ctx
    for l in range(DEPTH):
        last = l == DEPTH - 1
        shift, scale, gate = jnp.split(jax.nn.silu(c) @ ada_w[l] + ada_b[l], 3, axis=-1)
        shift_c, scale_c, gate_c = jnp.split(jax.nn.silu(c_ctx) @ ada_w[l] + ada_b[l], 3, axis=-1)
        h = rmsnorm(x, norm_g[l]) * (1.0 + scale[:, None]) + shift[:, None]
        hc = rmsnorm(xc, norm_g[l]) * (1.0 + scale_c) + shift_c

        if last:
            pkv = hc @ w_in[l][:, OFF_K:OFF_POOL]
            kc, vc = pkv[..., :KV_W], pkv[..., KV_W:]
        else:
            qc, kc, vc, upc, ufc, gc = split_proj(hc @ w_in[l])
        kc = rmsnorm(kc.reshape(B, C, N_KV_HEADS, HEAD_DIM), k_norm_g[l])
        vc = vc.reshape(B, C, N_KV_HEADS, HEAD_DIM)

        q, k, v, up, uf, g = split_proj(h @ w_in[l])
        q = apply_axial_rope(rmsnorm(q.reshape(B, N, N_HEADS, HEAD_DIM), q_norm_g[l]), cos, sin)
        k = apply_axial_rope(rmsnorm(k.reshape(B, N, N_KV_HEADS, HEAD_DIM), k_norm_g[l]), cos, sin)
        v = v.reshape(B, N, N_KV_HEADS, HEAD_DIM)
        att = latent_attention(q, k, v, kc, vc)
        out = merge_branches(att, up, uf, g, pool_w[l], pool_scale[l], fourier_w[l], w_out[l])
        x_new = x + gate[:, None] * out

        if not last:
            qc = rmsnorm(qc.reshape(B, C, N_HEADS, HEAD_DIM), q_norm_g[l])
            attc = context_attention(qc, kc, vc)
            outc = merge_branches(attc, upc, ufc, gc, pool_w[l], pool_scale[l], fourier_w[l], w_out[l])
            xc = xc + gate_c * outc
        x = x_new
    return rmsnorm(x, final_norm_g)
```

```cpp
#include <hip/hip_runtime.h>
#include <hip/hip_cooperative_groups.h>
#include <hip/hip_bf16.h>
#include <cstdio>
#include <cstdint>
namespace cg = cooperative_groups;

#ifndef MK_MULTI
#define MK_MULTI 0
#endif

constexpr int DM = 2048, NB = 8, SEQ = 2048, CTXL = 256, DEPTH = 2;
constexpr int ML = NB * SEQ, MC = NB * CTXL, MT = ML + MC, SKV = SEQ + CTXL;
constexpr int INW = 4608, OFFP = 1536, OFFF = 2048, OFFG = 2560;
constexpr float EPS = 1e-6f;
constexpr int NWAVES = 8, NTHR = 512;

constexpr size_t MiB = 1u << 20;
constexpr size_t WS_CTL = 0;
constexpr size_t WS_MODP = 1 * MiB;
constexpr size_t WS_MOD = 16 * MiB;
constexpr size_t WS_ROPE = 16 * MiB + 512 * 1024;
constexpr size_t WS_MFOLD = 17 * MiB;
constexpr size_t WS_WINT = 18 * MiB;
constexpr size_t WS_WFT = 50 * MiB;
constexpr size_t WS_WOUTT = 58 * MiB;
constexpr size_t WS_DFTL = 74 * MiB;
constexpr size_t WS_DFTC = 90 * MiB;
constexpr size_t WS_H = 91 * MiB;
constexpr size_t WS_QB = 163 * MiB;
constexpr size_t WS_KRAW = 199 * MiB;
constexpr size_t WS_KB = 208 * MiB;
constexpr size_t WS_VB = 217 * MiB;
constexpr size_t WS_UPW = 226 * MiB;
constexpr size_t WS_SG = 244 * MiB;
constexpr size_t WS_ABT = 316 * MiB;
constexpr size_t WS_ABTC = 348 * MiB;
constexpr size_t WS_XC1 = 352 * MiB;
constexpr size_t WS_END = 368 * MiB;

constexpr int RING_BYTES = 131072;
constexpr int OST_OFF = 66 * 1024;
constexpr int LDS_BYTES = 136 * 1024;

#define LAS __attribute__((address_space(3)))
typedef unsigned short bf16_t;
typedef short bf16x8 __attribute__((ext_vector_type(8)));
typedef float f32x4 __attribute__((ext_vector_type(4)));
typedef float f32x16 __attribute__((ext_vector_type(16)));
typedef short s16x4 __attribute__((ext_vector_type(4)));
typedef unsigned u32x4 __attribute__((ext_vector_type(4)));
typedef unsigned u32x2 __attribute__((ext_vector_type(2)));

__device__ __forceinline__ int opaque_tid() { int t = threadIdx.x; asm volatile("" : "+v"(t)); return t; }
template <class T> __device__ __forceinline__ T* opaque_ptr(T* p) { int z = 0; asm volatile("" : "+s"(z)); return p + z; }
__device__ __forceinline__ unsigned f2bf(float f) { unsigned u = __builtin_bit_cast(unsigned, f); return (u + 0x7fffu + ((u >> 16) & 1u)) >> 16; }
typedef float f32x2_t __attribute__((ext_vector_type(2))); typedef __bf16 bf16x2_t __attribute__((ext_vector_type(2)));
__device__ __forceinline__ unsigned pk2(float lo, float hi) { f32x2_t v = {lo, hi}; bf16x2_t b = __builtin_convertvector(v, bf16x2_t); return __builtin_bit_cast(unsigned, b); }
__device__ __forceinline__ float bf_lo(unsigned w) { return __builtin_bit_cast(float, w << 16); }
__device__ __forceinline__ float bf_hi(unsigned w) { return __builtin_bit_cast(float, w & 0xffff0000u); }
__device__ __forceinline__ float bf2f(bf16_t h) { return __builtin_bit_cast(float, (unsigned)h << 16); }
__device__ __forceinline__ unsigned cvt_pk_bf16(float lo, float hi) { return pk2(lo, hi); }
__device__ __forceinline__ float silu_f(float x) { return x / (1.0f + __expf(-x)); }
__device__ __forceinline__ float wave_sum(float v) {
#pragma unroll
    for (int o = 1; o < 64; o <<= 1) v += __shfl_xor(v, o);
    return v;
}
__device__ __forceinline__ int kvrow(int grow) {
    if (grow < ML) return (grow >> 11) * SKV + CTXL + (grow & 2047);
    const int rc = grow - ML; return (rc >> 8) * SKV + (rc & 255);
}

namespace pg8 {
constexpr int BM = 256, BK = 64, HALF = 128, HTB = HALF * BK * 2, NXCD = 8, WGM = 8;
__host__ __device__ __forceinline__ int lds_byte(int r, int c) { const int st = (r >> 4) * 2 + (c >> 5), rr = r & 15, cc = c & 31, ob = rr * 64 + cc * 2; return st * 1024 + (ob ^ (((ob >> 9) & 1) << 5)); }
__host__ __device__ __forceinline__ void stage_rc(int b, int& R, int& C) { const int st = b / 1024, sb = b % 1024, swz = sb ^ (((sb >> 9) & 1) << 5); R = (st >> 1) * 16 + swz / 64; C = (st & 1) * 32 + (swz % 64) / 2; }
__host__ __device__ __forceinline__ int perm32(int rho) { const int n = rho >> 4, i = rho & 15; return 8 * (i >> 2) + 4 * n + (i & 3); }

struct Unit { int pm, pn, z; };
struct Gemm { const bf16_t* A; const bf16_t* Bt; int lda, ldb, K; long zA, zB; };

struct StaticOrder {
    int nM, nN, nMN, nwg, G, c;
    __device__ void init(int nM_, int nN_, int nZ_, int G_, int c_) { nM = nM_; nN = nN_; nMN = nM_ * nN_; nwg = nMN * nZ_; G = G_; c = c_; }
    __device__ bool next(int i, Unit& u) const {
        const long L = (long)i * G + c; if (L >= nwg) return false;
        int wgid = (int)L; { const int q = nwg / NXCD, r = nwg % NXCD, xcd = wgid % NXCD, off = wgid / NXCD; wgid = (xcd < r ? xcd * (q + 1) : r * (q + 1) + (xcd - r) * q) + off; }
        u.z = wgid / nMN; wgid -= u.z * nMN;
        const int nig = WGM * nN, gid = wgid / nig, fm = gid * WGM, gsz = (nM - fm) < WGM ? (nM - fm) : WGM;
        u.pm = fm + ((wgid % nig) % gsz); u.pn = (wgid % nig) / gsz; return true;
    }
};

template <class Epi>
__device__ __forceinline__ void gemm_phase(LAS unsigned char* lds, const Gemm g, const StaticOrder& S, const Epi& E) {
    const int tid = opaque_tid(), wid = __builtin_amdgcn_readfirstlane(tid >> 6), lane = tid & 63, wr = wid >> 2, wc = wid & 3, fr = lane & 15, fq = lane >> 4;
    const int K = g.K, nt = K / BK;
    unsigned voffA[2], voffB[2];
#pragma unroll
    for (int i = 0; i < 2; ++i) { int R, C; stage_rc(tid * 16 + i * 8192, R, C); const int Rb = Epi::PERM ? ((R & ~31) + perm32(R & 31)) : R;
        voffA[i] = (unsigned)(R * g.lda + C) * 2u; voffB[i] = (unsigned)(Rb * g.ldb + C) * 2u; }
    const size_t kstep = (size_t)(BK * 2);
    const size_t hstepA = (size_t)HALF * g.lda * 2, hstepB = (size_t)HALF * g.ldb * 2;
    const unsigned ldsw = (unsigned)wid * 1024u;
    const int aoff = lds_byte(wr * 64 + fr, fq * 8), boff = lds_byte(wc * 32 + fr, fq * 8);
#define PG8_SA(b, h) (((b) * 2 + (h)) * HTB)
#define PG8_SB(b, h) ((4 + (b) * 2 + (h)) * HTB)
#define PG8_STAGE(bufoff, gbase, voff) do { _Pragma("unroll") for (int _i = 0; _i < 2; ++_i) \
        __builtin_amdgcn_global_load_lds((const unsigned*)((const char*)(gbase) + (voff)[_i]), (LAS unsigned*)(lds + (bufoff) + ldsw + _i * 8192), 16, 0, 0); } while (0)
#define PG8_LDA(dst, b, h) do { _Pragma("unroll") for (int m = 0; m < 4; ++m) _Pragma("unroll") for (int k = 0; k < 2; ++k) dst[m][k] = *(const LAS bf16x8*)(lds + PG8_SA(b, h) + aoff + m * 2048 + k * 1024); } while (0)
#define PG8_LDB(dst, b, h) do { _Pragma("unroll") for (int n = 0; n < 2; ++n) _Pragma("unroll") for (int k = 0; k < 2; ++k) dst[n][k] = *(const LAS bf16x8*)(lds + PG8_SB(b, h) + boff + n * 2048 + k * 1024); } while (0)
#define PG8_MMA(ai, bj, At, Bt) do { __builtin_amdgcn_s_setprio(1); _Pragma("unroll") for (int m = 0; m < 4; ++m) _Pragma("unroll") for (int n = 0; n < 2; ++n) _Pragma("unroll") for (int k = 0; k < 2; ++k) \
        acc[ai][bj][m][n] = __builtin_amdgcn_mfma_f32_16x16x32_bf16(Bt[n][k], At[m][k], acc[ai][bj][m][n], 0, 0, 0); __builtin_amdgcn_s_setprio(0); } while (0)
#define PG8_WAIT_V(n) asm volatile("s_waitcnt vmcnt(" #n ")" ::: "memory")
#define PG8_WAIT_L(n) asm volatile("s_waitcnt lgkmcnt(" #n ")" ::: "memory")
#define PG8_BAR __builtin_amdgcn_s_barrier()
#define PG8_SCHED __builtin_amdgcn_sched_barrier(0)
    Unit cur, nxt; int ui = 0;
    if (!S.next(0, cur)) return;
    f32x4 acc[2][2][4][2];
#pragma unroll
    for (int a = 0; a < 2; ++a)
#pragma unroll
        for (int b = 0; b < 2; ++b)
#pragma unroll
            for (int m = 0; m < 4; ++m)
#pragma unroll
                for (int n = 0; n < 2; ++n) acc[a][b][m][n] = (f32x4){0.f, 0.f, 0.f, 0.f};
    bf16x8 At[4][2], B0[2][2], B1[2][2];
    const char* cA = (const char*)g.A + ((size_t)cur.z * g.zA + (size_t)cur.pm * BM * g.lda) * 2;
    const char* cB = (const char*)g.Bt + ((size_t)cur.z * g.zB + (size_t)cur.pn * BM * g.ldb) * 2;
    PG8_STAGE(PG8_SB(0, 0), cB, voffB); PG8_STAGE(PG8_SB(0, 1), cB + hstepB, voffB); PG8_STAGE(PG8_SA(0, 0), cA, voffA); PG8_STAGE(PG8_SA(0, 1), cA + hstepA, voffA);
    if (wr == 1) PG8_BAR;
    PG8_WAIT_V(2); PG8_BAR;
    PG8_STAGE(PG8_SB(1, 0), cB + kstep, voffB); PG8_STAGE(PG8_SA(1, 0), cA + kstep, voffA); PG8_STAGE(PG8_SB(1, 1), cB + hstepB + kstep, voffB);
    PG8_WAIT_V(6); PG8_BAR;
    for (;;) {
        const bool has_next = S.next(ui + 1, nxt);
        const char* nA = has_next ? (const char*)g.A + ((size_t)nxt.z * g.zA + (size_t)nxt.pm * BM * g.lda) * 2 : cA;
        const char* nB = has_next ? (const char*)g.Bt + ((size_t)nxt.z * g.zB + (size_t)nxt.pn * BM * g.ldb) * 2 : cB;
        for (int t = 0; t < nt; t += 2) {
            const bool last = (t == nt - 2);
            const char* a1 = cA + (size_t)(t + 1) * kstep;
            const char* a2 = last ? nA : cA + (size_t)(t + 2) * kstep; const char* b2 = last ? nB : cB + (size_t)(t + 2) * kstep;
            const char* a3 = a2 + kstep; const char* b3 = b2 + kstep;
            PG8_LDB(B0, 0, 0); PG8_LDB(B1, 0, 1); PG8_SCHED; PG8_LDA(At, 0, 0); PG8_STAGE(PG8_SA(1, 1), a1 + hstepA, voffA);
            PG8_WAIT_V(8); PG8_WAIT_L(0); PG8_BAR; PG8_MMA(0, 0, At, B0); PG8_MMA(0, 1, At, B1); PG8_BAR; PG8_SCHED;
            PG8_LDA(At, 0, 1); PG8_STAGE(PG8_SB(0, 0), b2, voffB); PG8_STAGE(PG8_SB(0, 1), b2 + hstepB, voffB); PG8_STAGE(PG8_SA(0, 0), a2, voffA);
            PG8_WAIT_V(8); PG8_WAIT_L(0); PG8_BAR; PG8_MMA(1, 0, At, B0); PG8_MMA(1, 1, At, B1); PG8_BAR; PG8_SCHED;
            PG8_LDB(B0, 1, 0); PG8_LDB(B1, 1, 1); PG8_SCHED; PG8_LDA(At, 1, 0); PG8_STAGE(PG8_SA(0, 1), a2 + hstepA, voffA);
            PG8_WAIT_V(8); PG8_WAIT_L(0); PG8_BAR; PG8_MMA(0, 0, At, B0); PG8_MMA(0, 1, At, B1); PG8_BAR; PG8_SCHED;
            PG8_LDA(At, 1, 1); PG8_STAGE(PG8_SB(1, 0), b3, voffB); PG8_STAGE(PG8_SB(1, 1), b3 + hstepB, voffB); PG8_STAGE(PG8_SA(1, 0), a3, voffA);
            PG8_WAIT_V(8); PG8_WAIT_L(0); PG8_BAR; PG8_MMA(1, 0, At, B0); PG8_MMA(1, 1, At, B1); PG8_BAR; PG8_SCHED;
        }
        if (wr == 0) PG8_BAR;
        E(acc, cur, wr, wc, fr, fq);
        if (!has_next) break;
#pragma unroll
        for (int a = 0; a < 2; ++a)
#pragma unroll
            for (int b = 0; b < 2; ++b)
#pragma unroll
                for (int m = 0; m < 4; ++m)
#pragma unroll
                    for (int n = 0; n < 2; ++n) acc[a][b][m][n] = (f32x4){0.f, 0.f, 0.f, 0.f};
        cur = nxt; cA = nA; cB = nB; ++ui;
        if (wr == 1) PG8_BAR;
    }
    PG8_WAIT_V(0);
    PG8_BAR;
#undef PG8_SA
#undef PG8_SB
#undef PG8_STAGE
#undef PG8_LDA
#undef PG8_LDB
#undef PG8_MMA
#undef PG8_WAIT_V
#undef PG8_WAIT_L
#undef PG8_BAR
#undef PG8_SCHED
}
}

typedef const f32x4 (&AccRef)[2][2][4][2];
struct EpiInProj {
    static constexpr bool PERM = true;
    bf16_t *QB, *KRAW, *VB, *UPW, *SG; int row_off, pn_base;
    __device__ __forceinline__ void operator()(AccRef acc, const pg8::Unit& u, int wr, int wc, int fr, int fq) const {
        const int pn = u.pn + pn_base;
        bf16_t* base; int ld, ccol; bool act = false, kvmap = false;
        if (pn < 4) { base = QB; ld = 1024; ccol = pn * 256; }
        else if (pn == 4) { base = KRAW; ld = 256; ccol = 0; }
        else if (pn == 5) { base = VB; ld = 256; ccol = 0; kvmap = true; }
        else if (pn < 8) { base = UPW; ld = 512; ccol = (pn - 6) * 256; }
        else { base = SG; ld = 2048; ccol = (pn - 8) * 256; act = true; }
        const int row0 = row_off + u.pm * 256 + wr * 64 + fr, col0 = ccol + wc * 32 + 8 * fq;
#pragma unroll
        for (int ai = 0; ai < 2; ++ai)
#pragma unroll
            for (int m = 0; m < 4; ++m) {
                const int grow = row0 + ai * 128 + m * 16; const int drow = kvmap ? kvrow(grow) : grow;
                bf16_t* rowp = base + (size_t)drow * ld + col0;
#pragma unroll
                for (int bj = 0; bj < 2; ++bj) { f32x4 v0 = acc[ai][bj][m][0], v1 = acc[ai][bj][m][1];
                    if (act) {
#pragma unroll
                        for (int e = 0; e < 4; ++e) { v0[e] = silu_f(v0[e]); v1[e] = silu_f(v1[e]); } }
                    u32x4 w; w.x = cvt_pk_bf16(v0[0], v0[1]); w.y = cvt_pk_bf16(v0[2], v0[3]); w.z = cvt_pk_bf16(v1[0], v1[1]); w.w = cvt_pk_bf16(v1[2], v1[3]);
                    *(u32x4*)(rowp + bj * 128) = w; } }
    }
};
struct EpiFourT {
    static constexpr bool PERM = true;
    bf16_t *ABT, *ABTC;
    __device__ __forceinline__ void operator()(AccRef acc, const pg8::Unit& u, int wr, int wc, int fr, int fq) const {
        const int tok0 = u.pn * 256;
        bf16_t* base; int nlen, n0, b;
        if (tok0 < ML) { b = tok0 >> 11; n0 = tok0 & 2047; nlen = SEQ; base = ABT; }
        else { const int tc = tok0 - ML; b = tc >> 8; n0 = 0; nlen = CTXL; base = ABTC; }
        const int row0 = u.pm * 256 + wr * 64 + fr, col0 = n0 + wc * 32 + 8 * fq;
#pragma unroll
        for (int ai = 0; ai < 2; ++ai)
#pragma unroll
            for (int m = 0; m < 4; ++m) {
                const int row = row0 + ai * 128 + m * 16, part = row >> 9, ch = row & 511;
                bf16_t* rowp = base + (((size_t)b * 512 + ch) * 2 + part) * nlen + col0;
#pragma unroll
                for (int bj = 0; bj < 2; ++bj) { const f32x4 v0 = acc[ai][bj][m][0], v1 = acc[ai][bj][m][1];
                    u32x4 w; w.x = cvt_pk_bf16(v0[0], v0[1]); w.y = cvt_pk_bf16(v0[2], v0[3]); w.z = cvt_pk_bf16(v1[0], v1[1]); w.w = cvt_pk_bf16(v1[2], v1[3]);
                    *(u32x4*)(rowp + bj * 128) = w; } }
    }
};
struct EpiDft {
    static constexpr bool PERM = true;
    bf16_t* MIX; const bf16_t* SG; int row_base, rows_per_z; float norm;
    __device__ __forceinline__ void operator()(AccRef acc, const pg8::Unit& u, int wr, int wc, int fr, int fq) const {
        const int row0 = row_base + u.z * rows_per_z + u.pm * 256 + wr * 64 + fr, col0 = 1536 + u.pn * 256 + wc * 32 + 8 * fq;
#pragma unroll
        for (int ai = 0; ai < 2; ++ai) {
            u32x4 sg[4][2];
#pragma unroll
            for (int m = 0; m < 4; ++m)
#pragma unroll
                for (int bj = 0; bj < 2; ++bj) sg[m][bj] = *(const u32x4*)(SG + (size_t)(row0 + ai * 128 + m * 16) * 2048 + col0 + bj * 128);
#pragma unroll
            for (int m = 0; m < 4; ++m) {
                const size_t off = (size_t)(row0 + ai * 128 + m * 16) * 2048 + col0;
#pragma unroll
                for (int bj = 0; bj < 2; ++bj) { const f32x4 v0 = acc[ai][bj][m][0] * norm, v1 = acc[ai][bj][m][1] * norm;
                    const u32x4 s = sg[m][bj];
                    u32x4 w; w.x = cvt_pk_bf16(v0[0] * bf_lo(s.x), v0[1] * bf_hi(s.x)); w.y = cvt_pk_bf16(v0[2] * bf_lo(s.y), v0[3] * bf_hi(s.y));
                    w.z = cvt_pk_bf16(v1[0] * bf_lo(s.z), v1[1] * bf_hi(s.z)); w.w = cvt_pk_bf16(v1[2] * bf_lo(s.w), v1[3] * bf_hi(s.w));
                    *(u32x4*)(MIX + off + bj * 128) = w; } }
            asm volatile("" ::: "memory");
        }
    }
};
struct EpiOut {
    static constexpr bool PERM = false;
    const float* xsrc; const float* csrc; float* xdst; float* cdst; const float* mod;
    __device__ __forceinline__ void operator()(AccRef acc, const pg8::Unit& u, int wr, int wc, int fr, int fq) const {
        const int rowt = u.pm * 256; const bool lat = rowt < ML;
        const int modrow = lat ? (rowt >> 11) : 8;
        const float* src = lat ? xsrc + (size_t)rowt * 2048 : csrc + (size_t)(rowt - ML) * 2048;
        float* dst = lat ? xdst + (size_t)rowt * 2048 : cdst + (size_t)(rowt - ML) * 2048;
        const int col0 = u.pn * 256 + wc * 32 + 4 * fq;
        f32x4 gv[2][2];
#pragma unroll
        for (int bj = 0; bj < 2; ++bj)
#pragma unroll
            for (int n = 0; n < 2; ++n) gv[bj][n] = *(const f32x4*)(mod + (size_t)modrow * 6144 + 4096 + col0 + bj * 128 + n * 16);
#pragma unroll
        for (int ai = 0; ai < 2; ++ai)
#pragma unroll
            for (int m = 0; m < 4; ++m) { const size_t off = (size_t)(ai * 128 + wr * 64 + m * 16 + fr) * 2048 + col0;
#pragma unroll
                for (int bj = 0; bj < 2; ++bj)
#pragma unroll
                    for (int n = 0; n < 2; ++n) { const f32x4 xi = *(const f32x4*)(src + off + bj * 128 + n * 16);
                        *(f32x4*)(dst + off + bj * 128 + n * 16) = xi + gv[bj][n] * acc[ai][bj][m][n]; }
                if (m & 1) asm volatile("" ::: "memory"); }
    }
};

namespace att {
constexpr int D = 128, QBLK = 32, KVBLK = 64, LDQ = 1024, LDK = 256, LDO = 2048;
constexpr float SCALE = 0.088388347648318440f, THR = 8.f;
constexpr size_t SHM_V = KVBLK * D * 2, SHM_K = KVBLK * D * 2;
#define KSWZ(row, colB) ((row) * 256 + ((colB) ^ (((row) & 7) << 4)))
#define SBAR() __builtin_amdgcn_sched_barrier(0)
__device__ __forceinline__ int crow(int r, int hi) { return (r & 3) + 8 * (r >> 2) + 4 * hi; }
__device__ __forceinline__ unsigned cvtpk(float lo, float hi) { unsigned r; asm volatile("v_cvt_pk_bf16_f32 %0, %1, %2" : "=v"(r) : "v"(lo), "v"(hi)); return r; }
__device__ __forceinline__ void partialSM(f32x16& p0, f32x16& p1, float& m_reg, float& mn, float& alpha) {
  constexpr float C = SCALE * 1.4426950408889634f;
  float pmax = p0[0]; for (int r = 1; r < 16; ++r) pmax = fmaxf(pmax, p0[r]); for (int r = 0; r < 16; ++r) pmax = fmaxf(pmax, p1[r]);
  { auto rr = __builtin_amdgcn_permlane32_swap(__float_as_uint(pmax), __float_as_uint(pmax), false, false);
    pmax = fmaxf(__uint_as_float(rr[0]), __uint_as_float(rr[1])); }
  if (__builtin_expect(__all(pmax - m_reg <= THR / SCALE), 1)) { mn = m_reg; alpha = 1.f; }
  else { mn = fmaxf(m_reg, pmax); alpha = __builtin_amdgcn_exp2f((m_reg - mn) * C); m_reg = mn; }
  float mnC = -mn * C;
  for (int r = 0; r < 16; ++r) p0[r] = fmaf(p0[r], C, mnC); for (int r = 0; r < 16; ++r) p1[r] = fmaf(p1[r], C, mnC);
  for (int r = 0; r < 16; ++r) p0[r] = __builtin_amdgcn_exp2f(p0[r]);
}
__device__ __forceinline__ void finishSM(f32x16& p0, f32x16& p1, float alpha, float& l_reg, bf16x8& pa0, bf16x8& pa1, bf16x8& pa2, bf16x8& pa3) {
  for (int r = 0; r < 16; ++r) p1[r] = __builtin_amdgcn_exp2f(p1[r]);
  float ps = 0; for (int r = 0; r < 16; ++r) ps += p0[r]; for (int r = 0; r < 16; ++r) ps += p1[r];
  { auto rr = __builtin_amdgcn_permlane32_swap(__float_as_uint(ps), __float_as_uint(ps), false, false);
    ps = __uint_as_float(rr[0]) + __uint_as_float(rr[1]); }
  l_reg = l_reg * alpha + ps;
#define PK4(P, BASE, OUT) do { unsigned a0 = cvtpk(P[BASE + 0], P[BASE + 1]), a1 = cvtpk(P[BASE + 2], P[BASE + 3]);   \
    unsigned b0 = cvtpk(P[BASE + 4], P[BASE + 5]), b1 = cvtpk(P[BASE + 6], P[BASE + 7]);                              \
    auto r0 = __builtin_amdgcn_permlane32_swap(a0, b0, false, false); auto r1 = __builtin_amdgcn_permlane32_swap(a1, b1, false, false); \
    u32x4 w = {r0[0], r1[0], r0[1], r1[1]}; OUT = *reinterpret_cast<bf16x8*>(&w); } while (0)
  PK4(p0, 0, pa0); PK4(p0, 8, pa1); PK4(p1, 0, pa2); PK4(p1, 8, pa3);
#undef PK4
}
__device__ __forceinline__ void qkt(f32x16& p0, f32x16& p1, const bf16_t* Ks, const bf16x8* qr, int r32, int hi) {
  p0 = f32x16{}; p1 = f32x16{};
  for (int d0 = 0; d0 < 8; ++d0) { int cb = (d0 * 16 + hi * 8) * 2;
    bf16x8 b0 = *reinterpret_cast<const bf16x8*>((const char*)Ks + KSWZ(r32, cb));
    bf16x8 b1 = *reinterpret_cast<const bf16x8*>((const char*)Ks + KSWZ(32 + r32, cb));
    p0 = __builtin_amdgcn_mfma_f32_32x32x16_bf16(b0, qr[d0], p0, 0, 0, 0);
    p1 = __builtin_amdgcn_mfma_f32_32x32x16_bf16(b1, qr[d0], p1, 0, 0, 0); }
}
__device__ __forceinline__ int v_st(int k, int c) { const int kk = (k & ~0xC) | ((k & 4) << 1) | ((k & 8) >> 1); return ((kk >> 3) * 4 + (c >> 5)) * 512 + ((kk & 7) * 32 + (c & 31)) * 2; }
__device__ __forceinline__ int v_rd_base(int lane) { return ((lane & 3) << 3) | (((lane >> 2) & 3) << 6) | (((lane >> 4) & 1) << 5) | (((lane >> 5) & 1) << 8); }
constexpr int v_rd_off(int d0, int ks, int half) { return d0 * 512 + ks * 4096 + half * 2048; }
template <int OFF> __device__ __forceinline__ s16x4 tr_read(int vb) {
  s16x4 r; asm volatile("ds_read_b64_tr_b16 %0, %1 offset:%2" : "=&v"(r) : "v"(vb), "i"(OFF) : "memory"); return r;
}
template <int D0> __device__ __forceinline__ void pv_one(f32x16& od, int vb, bf16x8 pa0, bf16x8 pa1, bf16x8 pa2, bf16x8 pa3) {
  const s16x4 l0 = tr_read<v_rd_off(D0, 0, 0)>(vb), h0 = tr_read<v_rd_off(D0, 0, 1)>(vb), l1 = tr_read<v_rd_off(D0, 1, 0)>(vb), h1 = tr_read<v_rd_off(D0, 1, 1)>(vb);
  const s16x4 l2 = tr_read<v_rd_off(D0, 2, 0)>(vb), h2 = tr_read<v_rd_off(D0, 2, 1)>(vb), l3 = tr_read<v_rd_off(D0, 3, 0)>(vb), h3 = tr_read<v_rd_off(D0, 3, 1)>(vb);
  asm volatile("s_waitcnt lgkmcnt(0)" ::: "memory"); SBAR();
#define PK(L, H) (bf16x8){L[0], L[1], L[2], L[3], H[0], H[1], H[2], H[3]}
  od = __builtin_amdgcn_mfma_f32_32x32x16_bf16(pa0, PK(l0, h0), od, 0, 0, 0);
  od = __builtin_amdgcn_mfma_f32_32x32x16_bf16(pa1, PK(l1, h1), od, 0, 0, 0);
  od = __builtin_amdgcn_mfma_f32_32x32x16_bf16(pa2, PK(l2, h2), od, 0, 0, 0);
  od = __builtin_amdgcn_mfma_f32_32x32x16_bf16(pa3, PK(l3, h3), od, 0, 0, 0);
#undef PK
}
__device__ __forceinline__ void pv_d0(f32x16* o, int vb, bf16x8 pa0, bf16x8 pa1, bf16x8 pa2, bf16x8 pa3) {
  pv_one<0>(o[0], vb, pa0, pa1, pa2, pa3); pv_one<1>(o[1], vb, pa0, pa1, pa2, pa3); pv_one<2>(o[2], vb, pa0, pa1, pa2, pa3); pv_one<3>(o[3], vb, pa0, pa1, pa2, pa3);
}
__device__ __forceinline__ void attn_dense_body(const bf16_t* __restrict__ Qb, const bf16_t* __restrict__ Kh, const bf16_t* __restrict__ Vh,
                                                const bf16_t* __restrict__ Gb, bf16_t* __restrict__ Mb, int seq, char* lds) {
  const int tid = opaque_tid(), wid = tid >> 6, lane = tid & 63, r32 = lane & 31, hi = lane >> 5;
  bf16_t* V_lds = (bf16_t*)lds; bf16_t* K_lds = (bf16_t*)(lds + 2 * SHM_V);
  float* ws = (float*)(lds + 2 * SHM_V + 2 * SHM_K) + wid * 64; float* li_l = ws; float* al_l = ws + 32;
  float m_reg = -1e30f, l_reg = 0; f32x16 o[4] = {}; bf16x8 qr[8];
  const bf16_t* Qw = Qb + (long)(wid * QBLK + r32) * LDQ + hi * 8;
#pragma unroll
  for (int d0 = 0; d0 < 8; ++d0) qr[d0] = *reinterpret_cast<const bf16x8*>(Qw + d0 * 16);
  const int sr = tid >> 4, sc = (tid & 15) * 8, vst0 = v_st(sr, sc), vst1 = v_st(32 + sr, sc);
  const int vb0 = (int)(uintptr_t)V_lds + v_rd_base(lane);
  struct { bf16x8 vs0, vs1, ks0, ks1; } sr_[2];
#define SLOAD(i, k0) do { sr_[i].vs0 = *reinterpret_cast<const bf16x8*>(&Vh[(long)((k0) + sr) * LDK + sc]); sr_[i].vs1 = *reinterpret_cast<const bf16x8*>(&Vh[(long)((k0) + 32 + sr) * LDK + sc]); \
    sr_[i].ks0 = *reinterpret_cast<const bf16x8*>(&Kh[(long)((k0) + sr) * LDK + sc]); sr_[i].ks1 = *reinterpret_cast<const bf16x8*>(&Kh[(long)((k0) + 32 + sr) * LDK + sc]); } while (0)
#define SWRITE(b, i) do { *(bf16x8*)((char*)V_lds + (b) * SHM_V + vst0) = sr_[i].vs0;          \
    *(bf16x8*)((char*)V_lds + (b) * SHM_V + vst1) = sr_[i].vs1; int kc = sc * 2;               \
    *(bf16x8*)((char*)K_lds + (b) * SHM_K + KSWZ(sr, kc)) = sr_[i].ks0;                       \
    *(bf16x8*)((char*)K_lds + (b) * SHM_K + KSWZ(32 + sr, kc)) = sr_[i].ks1; } while (0)
#define SWAIT() asm volatile("s_waitcnt vmcnt(4)" ::: "memory")
#define RESC(a) do { if (__any((a) < 1.f)) { if (hi == 0) al_l[r32] = (a); asm volatile("s_waitcnt lgkmcnt(0)" ::: "memory"); \
    for (int d = 0; d < 4; ++d) for (int r = 0; r < 16; ++r) o[d][r] *= al_l[crow(r, hi)]; } } while (0)
  f32x16 pA0, pA1, pB0, pB1; float mnA, mnB, alA, alB; bf16x8 pa0, pa1, pa2, pa3; const int NT = seq / KVBLK;
  constexpr int SE = 0, SO = 1;
  SLOAD(SE, 0); asm volatile("s_waitcnt vmcnt(0)" ::: "memory"); SWRITE(0, SE); __syncthreads();
  qkt(pA0, pA1, K_lds, qr, r32, hi); partialSM(pA0, pA1, m_reg, mnA, alA);
  SLOAD(SO, KVBLK); if (2 < NT) SLOAD(SE, 2 * KVBLK);
  SWAIT(); SWRITE(1, SO); __syncthreads();
  for (int j = 1; j + 1 < NT; j += 2) {
    SBAR(); qkt(pB0, pB1, (bf16_t*)((char*)K_lds + SHM_K), qr, r32, hi);
    finishSM(pA0, pA1, alA, l_reg, pa0, pa1, pa2, pa3); SBAR();
    SLOAD(SO, (j + 2) * KVBLK); SBAR();
    pv_d0(o, vb0, pa0, pa1, pa2, pa3); partialSM(pB0, pB1, m_reg, mnB, alB);
    __syncthreads(); SWAIT(); SWRITE(0, SE);
    RESC(alB); __syncthreads();
    SBAR(); qkt(pA0, pA1, K_lds, qr, r32, hi);
    finishSM(pB0, pB1, alB, l_reg, pa0, pa1, pa2, pa3); SBAR();
    if (j + 3 < NT) SLOAD(SE, (j + 3) * KVBLK); SBAR();
    pv_d0(o, vb0 + (int)SHM_V, pa0, pa1, pa2, pa3); partialSM(pA0, pA1, m_reg, mnA, alA);
    __syncthreads(); SWAIT(); SWRITE(1, SO);
    RESC(alA); __syncthreads();
  }
  SBAR(); qkt(pB0, pB1, (bf16_t*)((char*)K_lds + SHM_K), qr, r32, hi);
  finishSM(pA0, pA1, alA, l_reg, pa0, pa1, pa2, pa3); SBAR();
  pv_d0(o, vb0, pa0, pa1, pa2, pa3); partialSM(pB0, pB1, m_reg, mnB, alB);
  __syncthreads(); RESC(alB);
  finishSM(pB0, pB1, alB, l_reg, pa0, pa1, pa2, pa3); SBAR();
  pv_d0(o, vb0 + (int)SHM_V, pa0, pa1, pa2, pa3);
  if (hi == 0) li_l[r32] = l_reg; asm volatile("s_waitcnt lgkmcnt(0)" ::: "memory");
  float rli[16];
#pragma unroll
  for (int r = 0; r < 16; ++r) rli[r] = __builtin_amdgcn_rcpf(li_l[crow(r, hi)]);
  bf16_t* stg = (bf16_t*)(lds + OST_OFF) + wid * 4096;
#pragma unroll
  for (int r = 0; r < 16; ++r) { const int orow = crow(r, hi);
#pragma unroll
    for (int d0 = 0; d0 < 4; ++d0) stg[orow * 128 + d0 * 32 + r32] = (bf16_t)f2bf(o[d0][r] * rli[r]); }
  asm volatile("s_waitcnt lgkmcnt(0)" ::: "memory");
#pragma unroll
  for (int i = 0; i < 8; ++i) { const int row = i * 4 + (lane >> 4), ch = lane & 15;
    const u32x4 v = *(const u32x4*)(stg + row * 128 + ch * 8);
    const size_t off = (size_t)(wid * QBLK + row) * LDO + ch * 8;
    const u32x4 s = *(const u32x4*)(Gb + off);
    u32x4 w; w.x = pk2(bf_lo(v.x) * bf_lo(s.x), bf_hi(v.x) * bf_hi(s.x)); w.y = pk2(bf_lo(v.y) * bf_lo(s.y), bf_hi(v.y) * bf_hi(s.y));
    w.z = pk2(bf_lo(v.z) * bf_lo(s.z), bf_hi(v.z) * bf_hi(s.z)); w.w = pk2(bf_lo(v.w) * bf_lo(s.w), bf_hi(v.w) * bf_hi(s.w));
    *(u32x4*)(Mb + off) = w; }
  asm volatile("s_waitcnt lgkmcnt(0)" ::: "memory");
  __syncthreads();
#undef SLOAD
#undef SWRITE
#undef SWAIT
#undef RESC
}
#undef KSWZ
#undef SBAR
}

struct Args {
    const float *x, *c, *ctx, *c_ctx, *ada_w, *ada_b, *norm_g, *w_in, *q_norm_g, *k_norm_g, *pool_w, *pool_scale, *fourier_w, *w_out, *final_norm_g;
    float* out; unsigned char* ws; int ph_lo, ph_hi;
};

__device__ __forceinline__ void transpose_item(const float* W, int ldw, int col0, int ncols, bf16_t* WT, int dst_row0, LAS float* scr, int item, int lane) {
    const int nblk = ncols / 32, kb = item / nblk, nb = item % nblk, k0 = 64 * kb, n0 = 32 * nb;
#pragma unroll 8
    for (int i = 0; i < 32; ++i) { const int kk = 2 * i + (lane >> 5); scr[kk * 33 + (lane & 31)] = W[(size_t)(k0 + kk) * ldw + col0 + n0 + (lane & 31)]; }
    asm volatile("s_waitcnt lgkmcnt(0)" ::: "memory");
    const int cidx = lane & 7;
#pragma unroll
    for (int j = 0; j < 4; ++j) { const int n = (lane >> 3) + 8 * j; const LAS float* s = scr + (8 * cidx) * 33 + n;
        u32x4 o; o.x = pk2(s[0 * 33], s[1 * 33]); o.y = pk2(s[2 * 33], s[3 * 33]); o.z = pk2(s[4 * 33], s[5 * 33]); o.w = pk2(s[6 * 33], s[7 * 33]);
        *(u32x4*)(WT + (size_t)(dst_row0 + n0 + n) * 2048 + k0 + 8 * cidx) = o; }
    asm volatile("s_waitcnt lgkmcnt(0)" ::: "memory");
}

__device__ __forceinline__ void phase_p0a(const Args& a, LAS unsigned char* lds, int vcu, int G) {
    const int tid = opaque_tid(), lane = tid & 63, wave = __builtin_amdgcn_readfirstlane(tid >> 6);
    const int gw = vcu * NWAVES + wave, NGW = G * NWAVES;
    const int gt = vcu * NTHR + tid, NGT = G * NTHR;
    unsigned char* ws = opaque_ptr(a.ws);
    {
        float* modp = (float*)(ws + WS_MODP);
        for (int it = gw; it < 2 * 24 * 32; it += NGW) {
            const int kc = it & 31, cc = (it >> 5) % 24, l = it / (32 * 24);
            const int k = kc * 64 + lane;
            float sv[9];
#pragma unroll
            for (int r = 0; r < 8; ++r) sv[r] = silu_f(a.c[r * 2048 + k]);
            sv[8] = silu_f(a.c_ctx[k]);
            f32x4 acc[9];
#pragma unroll
            for (int r = 0; r < 9; ++r) acc[r] = (f32x4){0.f, 0.f, 0.f, 0.f};
            const float* wp = a.ada_w + ((size_t)l * 2048 + kc * 64) * 6144 + cc * 256 + lane * 4;
#pragma unroll 4
            for (int kk = 0; kk < 64; ++kk) {
                const f32x4 w = *(const f32x4*)(wp + (size_t)kk * 6144);
#pragma unroll
                for (int r = 0; r < 9; ++r) { const float s = __shfl(sv[r], kk); acc[r] += w * s; }
            }
#pragma unroll
            for (int r = 0; r < 9; ++r) *(f32x4*)(modp + (((size_t)kc * 2 + l) * 9 + r) * 6144 + cc * 256 + lane * 4) = acc[r];
        }
    }
    {
        LAS float* scr = (LAS float*)(lds + wave * 16384);
        constexpr int I_QKV = 32 * 48, I_G = 32 * 64, I_O = 32 * 64, I_L = I_QKV + I_G + I_O;
        for (int it = gw; it < 2 * I_L; it += NGW) {
            const int l = it / I_L; int r = it % I_L;
            const float* win = a.w_in + (size_t)l * 2048 * INW;
            bf16_t* wint = (bf16_t*)(ws + WS_WINT) + (size_t)l * 4096 * 2048;
            if (r < I_QKV) { transpose_item(win, INW, 0, 1536, wint, 0, scr, r, lane); continue; } r -= I_QKV;
            if (r < I_G) { transpose_item(win, INW, OFFG, 2048, wint, 2048, scr, r, lane); continue; } r -= I_G;
            transpose_item(a.w_out + (size_t)l * 2048 * 2048, 2048, 0, 2048, (bf16_t*)(ws + WS_WOUTT) + (size_t)l * 2048 * 2048, 0, scr, r, lane);
        }
    }
    {
        bf16_t* dl = (bf16_t*)(ws + WS_DFTL);
        for (int ch = gt; ch < 2048 * 512; ch += NGT) {
            const int k = ch >> 9, j0 = (ch & 511) * 8, part = j0 >> 11, n0 = j0 & 2047;
            float v[8];
#pragma unroll
            for (int e = 0; e < 8; ++e) { const int idx = (k * (n0 + e)) & 2047; const float t = (float)idx * (1.0f / 1024.0f); v[e] = part ? -sinpif(t) : cospif(t); }
            u32x4 o; o.x = pk2(v[0], v[1]); o.y = pk2(v[2], v[3]); o.z = pk2(v[4], v[5]); o.w = pk2(v[6], v[7]);
            *(u32x4*)(dl + (size_t)k * 4096 + j0) = o;
        }
        bf16_t* dc = (bf16_t*)(ws + WS_DFTC);
        for (int ch = gt; ch < 256 * 64; ch += NGT) {
            const int k = ch >> 6, j0 = (ch & 63) * 8, part = j0 >> 8, n0 = j0 & 255;
            float v[8];
#pragma unroll
            for (int e = 0; e < 8; ++e) { const int idx = (k * (n0 + e)) & 255; const float t = (float)idx * (1.0f / 128.0f); v[e] = part ? -sinpif(t) : cospif(t); }
            u32x4 o; o.x = pk2(v[0], v[1]); o.y = pk2(v[2], v[3]); o.z = pk2(v[4], v[5]); o.w = pk2(v[6], v[7]);
            *(u32x4*)(dc + (size_t)k * 512 + j0) = o;
        }
    }
    {
        float* rc = (float*)(ws + WS_ROPE); float* rs = rc + 2048;
        for (int e = gt; e < 2048; e += NGT) { const int p = e >> 5, i = e & 31;
            const float inv = powf(10000.0f, -(float)(2 * i) / 64.0f); const float ang = (float)p * inv;
            rc[e] = cosf(ang); rs[e] = sinf(ang); }
    }
    {
        float* mf = (float*)(ws + WS_MFOLD);
        for (int e = gt; e < 2 * 4 * 2 * 128 * 128; e += NGT) {
            const int d = e & 127, cch = (e >> 7) & 127, part = (e >> 14) & 1, lg = e >> 15;
            const float* fw = a.fourier_w + (size_t)lg * 128 * 128 + d;
            float s = 0.f;
            for (int m = 0; m < 128; ++m) { const float t = (float)((m * cch) & 127) * (1.0f / 64.0f); const float tr = part ? sinpif(t) : cospif(t); s = fmaf(tr, fw[m * 128], s); }
            mf[e] = s;
        }
    }
}

__device__ __forceinline__ void phase_p0b(const Args& a, int vcu, int G) {
    const int tid = opaque_tid(), lane = tid & 63, wave = __builtin_amdgcn_readfirstlane(tid >> 6);
    const int gw = vcu * NWAVES + wave, NGW = G * NWAVES;
    const int gt = vcu * NTHR + tid, NGT = G * NTHR;
    unsigned char* ws = opaque_ptr(a.ws);
    {
        const float* modp = (const float*)(ws + WS_MODP); float* mod = (float*)(ws + WS_MOD);
        for (int e = gt; e < 2 * 9 * 6144; e += NGT) {
            const int l = e / (9 * 6144), col = e % 6144; const int rem = e - l * 9 * 6144;
            float s = a.ada_b[l * 6144 + col];
            for (int kc = 0; kc < 32; ++kc) s += modp[((size_t)kc * 2 + l) * 9 * 6144 + rem];
            mod[e] = s;
        }
    }
    {
        for (int it = gw; it < 24 * 8 * 32; it += NGW) {
            const int kc = it & 31, dch = (it >> 5) & 7, mat = it >> 8;
            const int l = mat / 12, mm = mat % 12;
            const float* Mat; bf16_t* dst; int col0;
            if (mm < 4) { const int g = mm; Mat = a.pool_w + (size_t)(l * 4 + g) * 128 * 128; col0 = OFFP + g * 128;
                dst = (bf16_t*)(ws + WS_WINT) + ((size_t)l * 4096 + 1536 + g * 128) * 2048; }
            else { const int part = (mm - 4) >> 2, g = (mm - 4) & 3; Mat = (const float*)(ws + WS_MFOLD) + (size_t)((l * 4 + g) * 2 + part) * 128 * 128; col0 = OFFF + g * 128;
                dst = (bf16_t*)(ws + WS_WFT) + ((size_t)l * 1024 + part * 512 + g * 128) * 2048; }
            const int k = kc * 64 + lane, d0 = dch * 16;
            const float* wrow = a.w_in + ((size_t)l * 2048 + k) * INW + col0;
            float acc[16];
#pragma unroll
            for (int d = 0; d < 16; ++d) acc[d] = 0.f;
            for (int c4 = 0; c4 < 32; ++c4) {
                const f32x4 w = *(const f32x4*)(wrow + c4 * 4);
#pragma unroll
                for (int i = 0; i < 4; ++i) { const float* mr = Mat + (size_t)(c4 * 4 + i) * 128 + d0;
#pragma unroll
                    for (int d = 0; d < 16; ++d) acc[d] = fmaf(w[i], mr[d], acc[d]); }
            }
#pragma unroll
            for (int d = 0; d < 16; ++d) dst[(size_t)(d0 + d) * 2048 + k] = (bf16_t)f2bf(acc[d]);
        }
    }
}

__device__ __forceinline__ void phase_p1(const Args& a, int l, int vcu, int G) {
    const int tid = opaque_tid(), lane = tid & 63, wave = __builtin_amdgcn_readfirstlane(tid >> 6);
    const int gw = vcu * NWAVES + wave, NGW = G * NWAVES;
    unsigned char* ws = opaque_ptr(a.ws);
    const float* mod = (const float*)(ws + WS_MOD) + (size_t)l * 9 * 6144;
    const float* xl = l == 0 ? a.x : a.out; const float* xc = l == 0 ? a.ctx : (const float*)(ws + WS_XC1);
    const float* ng = a.norm_g + l * 2048;
    bf16_t* H = (bf16_t*)(ws + WS_H);
    for (int row = gw; row < MT; row += NGW) {
        const bool lat = row < ML; const int modrow = lat ? (row >> 11) : 8;
        const float* src = lat ? xl + (size_t)row * 2048 : xc + (size_t)(row - ML) * 2048;
        const f32x4* xr = (const f32x4*)src + lane;
        f32x4 v[8]; float s = 0.f;
#pragma unroll
        for (int j = 0; j < 8; ++j) { v[j] = xr[64 * j]; s += (v[j].x * v[j].x + v[j].y * v[j].y) + (v[j].z * v[j].z + v[j].w * v[j].w); }
        const float rstd = 1.0f / sqrtf(wave_sum(s) * (1.0f / 2048.0f) + EPS);
        const f32x4* gp = (const f32x4*)ng + lane; const f32x4* shp = (const f32x4*)(mod + (size_t)modrow * 6144) + lane; const f32x4* scp = (const f32x4*)(mod + (size_t)modrow * 6144 + 2048) + lane;
        u32x2* op = (u32x2*)(H + (size_t)row * 2048) + lane;
#pragma unroll
        for (int j = 0; j < 8; ++j) { const f32x4 g = gp[64 * j], sh = shp[64 * j], sc = scp[64 * j];
            const f32x4 y = (v[j] * rstd) * g * (sc + 1.0f) + sh;
            u32x2 w; w.x = pk2(y.x, y.y); w.y = pk2(y.z, y.w); op[64 * j] = w; }
    }
}

__device__ __forceinline__ void phase_p2b(const Args& a, int l, int vcu, int G) {
    const int tid = opaque_tid(), lane = tid & 63, wave = __builtin_amdgcn_readfirstlane(tid >> 6);
    const int gw = vcu * NWAVES + wave, NGW = G * NWAVES;
    unsigned char* ws = opaque_ptr(a.ws);
    bf16_t* QB = (bf16_t*)(ws + WS_QB); const bf16_t* KRAW = (const bf16_t*)(ws + WS_KRAW); bf16_t* KB = (bf16_t*)(ws + WS_KB);
    const float* rc = (const float*)(ws + WS_ROPE); const float* rs = rc + 2048;
    const int axis = lane >> 5, i = lane & 31, d1 = axis * 64 + i, d2 = d1 + 32;
    const float qg1 = a.q_norm_g[l * 128 + d1], qg2 = a.q_norm_g[l * 128 + d2], kg1 = a.k_norm_g[l * 128 + d1], kg2 = a.k_norm_g[l * 128 + d2];
    for (int row = gw; row < MT; row += NGW) {
        const bool lat = row < ML;
        float cs = 1.f, sn = 0.f;
        if (lat) { const int n = row & 2047, p = axis ? (n & 63) : (n >> 6); cs = rc[p * 32 + i]; sn = rs[p * 32 + i]; }
        const int h0 = (!lat && l == DEPTH - 1) ? 8 : 0;
        const int krow = kvrow(row);
        for (int h = h0; h < 10; ++h) {
            const bool isq = h < 8;
            const bf16_t* src = isq ? QB + (size_t)row * 1024 + h * 128 : KRAW + (size_t)row * 256 + (h - 8) * 128;
            bf16_t* dst = isq ? QB + (size_t)row * 1024 + h * 128 : KB + (size_t)krow * 256 + (h - 8) * 128;
            const float x1 = bf2f(src[d1]), x2 = bf2f(src[d2]);
            const float ss = wave_sum(x1 * x1 + x2 * x2);
            const float rstd = 1.0f / sqrtf(ss * (1.0f / 128.0f) + EPS);
            const float y1 = x1 * rstd * (isq ? qg1 : kg1), y2 = x2 * rstd * (isq ? qg2 : kg2);
            dst[d1] = (bf16_t)f2bf(y1 * cs - y2 * sn); dst[d2] = (bf16_t)f2bf(y2 * cs + y1 * sn);
        }
    }
}

__device__ __forceinline__ void phase_pool(const Args& a, int l, int vcu, int G) {
    const int tid = opaque_tid(); const int gt = vcu * NTHR + tid, NGT = G * NTHR;
    unsigned char* ws = opaque_ptr(a.ws);
    const bf16_t* UPW = (const bf16_t*)(ws + WS_UPW); const bf16_t* SG = (const bf16_t*)(ws + WS_SG); bf16_t* MIX = (bf16_t*)(ws + WS_H);
    const int nrows = (l == 0) ? MT : ML;
    for (int it = gt; it < nrows * 64; it += NGT) {
        const int row = it >> 6, chunk = it & 63, gi = chunk >> 4, hw = 1 << gi;
        int t, nseq, seq0;
        if (row < ML) { t = row & 2047; nseq = SEQ; seq0 = row - t; } else { const int rc = row - ML; t = rc & 255; nseq = CTXL; seq0 = row - t; }
        const int lo = max(t - hw, 0), hi = min(t + hw - 1, nseq - 1);
        float s[8];
#pragma unroll
        for (int e = 0; e < 8; ++e) s[e] = 0.f;
        for (int j = lo; j <= hi; ++j) { const u32x4 v = *(const u32x4*)(UPW + (size_t)(seq0 + j) * 512 + chunk * 8);
            s[0] += bf_lo(v.x); s[1] += bf_hi(v.x); s[2] += bf_lo(v.y); s[3] += bf_hi(v.y); s[4] += bf_lo(v.z); s[5] += bf_hi(v.z); s[6] += bf_lo(v.w); s[7] += bf_hi(v.w); }
        const float rcnt = 1.0f / (float)(hi - lo + 1);
        const u32x4 own = *(const u32x4*)(UPW + (size_t)row * 512 + chunk * 8);
        const u32x4 sg = *(const u32x4*)(SG + (size_t)row * 2048 + 1024 + chunk * 8);
        const f32x4 ps0 = *(const f32x4*)(a.pool_scale + l * 512 + chunk * 8), ps1 = *(const f32x4*)(a.pool_scale + l * 512 + chunk * 8 + 4);
        float y[8];
        y[0] = (s[0] * rcnt - bf_lo(own.x)) * ps0[0] * bf_lo(sg.x); y[1] = (s[1] * rcnt - bf_hi(own.x)) * ps0[1] * bf_hi(sg.x);
        y[2] = (s[2] * rcnt - bf_lo(own.y)) * ps0[2] * bf_lo(sg.y); y[3] = (s[3] * rcnt - bf_hi(own.y)) * ps0[3] * bf_hi(sg.y);
        y[4] = (s[4] * rcnt - bf_lo(own.z)) * ps1[0] * bf_lo(sg.z); y[5] = (s[5] * rcnt - bf_hi(own.z)) * ps1[1] * bf_hi(sg.z);
        y[6] = (s[6] * rcnt - bf_lo(own.w)) * ps1[2] * bf_lo(sg.w); y[7] = (s[7] * rcnt - bf_hi(own.w)) * ps1[3] * bf_hi(sg.w);
        u32x4 o; o.x = pk2(y[0], y[1]); o.y = pk2(y[2], y[3]); o.z = pk2(y[4], y[5]); o.w = pk2(y[6], y[7]);
        *(u32x4*)(MIX + (size_t)row * 2048 + 1024 + chunk * 8) = o;
    }
}

__device__ __forceinline__ void phase_final(const Args& a, int vcu, int G) {
    const int tid = opaque_tid(), lane = tid & 63, wave = __builtin_amdgcn_readfirstlane(tid >> 6);
    const int gw = vcu * NWAVES + wave, NGW = G * NWAVES;
    for (int row = gw; row < ML; row += NGW) {
        f32x4* xr = (f32x4*)(a.out + (size_t)row * 2048) + lane;
        f32x4 v[8]; float s = 0.f;
#pragma unroll
        for (int j = 0; j < 8; ++j) { v[j] = xr[64 * j]; s += (v[j].x * v[j].x + v[j].y * v[j].y) + (v[j].z * v[j].z + v[j].w * v[j].w); }
        const float rstd = 1.0f / sqrtf(wave_sum(s) * (1.0f / 2048.0f) + EPS);
        const f32x4* gp = (const f32x4*)a.final_norm_g + lane;
#pragma unroll
        for (int j = 0; j < 8; ++j) xr[64 * j] = (v[j] * rstd) * gp[64 * j];
    }
}

constexpr int N_PHASES = 13;
__global__ void __launch_bounds__(NTHR, 2) mega_fwd(Args a) {
    extern __shared__ __attribute__((aligned(16))) unsigned char lds_raw[];
    LAS unsigned char* lds = (LAS unsigned char*)lds_raw;
    const int G = gridDim.x, bx = blockIdx.x;
    const int vcu = (G % 8 == 0) ? (bx % 8) * (G / 8) + bx / 8 : bx;
    unsigned char* ws = opaque_ptr(a.ws);
    bf16_t* H = (bf16_t*)(ws + WS_H); bf16_t* QB = (bf16_t*)(ws + WS_QB); bf16_t* KRAW = (bf16_t*)(ws + WS_KRAW);
    bf16_t* KB = (bf16_t*)(ws + WS_KB); bf16_t* VB = (bf16_t*)(ws + WS_VB); bf16_t* UPW = (bf16_t*)(ws + WS_UPW); bf16_t* SG = (bf16_t*)(ws + WS_SG);
    bf16_t* ABT = (bf16_t*)(ws + WS_ABT); bf16_t* ABTC = (bf16_t*)(ws + WS_ABTC);

    for (int ph = a.ph_lo; ph < a.ph_hi; ++ph) {
        if (ph == 0) phase_p0a(a, lds, vcu, G);
        else if (ph == 1) phase_p0b(a, vcu, G);
        else if (ph == N_PHASES - 1) phase_final(a, vcu, G);
        else {
            const int l = (ph - 2) / 5, s = (ph - 2) % 5;
            const bf16_t* WINT = (const bf16_t*)(ws + WS_WINT) + (size_t)l * 4096 * 2048;
            const bf16_t* WFT = (const bf16_t*)(ws + WS_WFT) + (size_t)l * 1024 * 2048;
            const bf16_t* WOUTT = (const bf16_t*)(ws + WS_WOUTT) + (size_t)l * 2048 * 2048;
            if (s == 0) phase_p1(a, l, vcu, G);
            else if (s == 1) {
                { pg8::Gemm g{H, WINT, 2048, 2048, 2048, 0, 0}; pg8::StaticOrder S; S.init((l == 0 ? MT : ML) / 256, 16, 1, G, bx);
                  EpiInProj E{QB, KRAW, VB, UPW, SG, 0, 0}; pg8::gemm_phase<EpiInProj>(lds, g, S, E); }
                if (l != 0) { pg8::Gemm g{H + (size_t)ML * 2048, WINT + (size_t)1024 * 2048, 2048, 2048, 2048, 0, 0}; pg8::StaticOrder S; S.init(MC / 256, 2, 1, G, (bx + 64) % G);
                  EpiInProj E{QB, KRAW, VB, UPW, SG, ML, 4}; pg8::gemm_phase<EpiInProj>(lds, g, S, E); }
                { pg8::Gemm g{WFT, H, 2048, 2048, 2048, 0, 0}; pg8::StaticOrder S; S.init(4, (l == 0 ? MT : ML) / 256, 1, G, (bx + 128) % G);
                  EpiFourT E{ABT, ABTC}; pg8::gemm_phase<EpiFourT>(lds, g, S, E); }
            }
            else if (s == 2) phase_p2b(a, l, vcu, G);
            else if (s == 3) {
                const int nU = 512 + (l == 0 ? 64 : 0);
                for (int i = vcu; i < nU; i += G) {
                    int b, h, kvh, seq; size_t qrow0;
                    if (i < 512) { const int pair = i >> 5, w = i & 31; b = pair >> 1; kvh = pair & 1; h = kvh * 4 + (w >> 3); qrow0 = (size_t)b * SEQ + (w & 7) * 256; seq = SKV; }
                    else { const int j = i - 512; b = j >> 3; h = j & 7; kvh = h >> 2; qrow0 = (size_t)ML + b * CTXL; seq = CTXL; }
                    att::attn_dense_body(QB + qrow0 * 1024 + h * 128, KB + (size_t)b * SKV * 256 + kvh * 128, VB + (size_t)b * SKV * 256 + kvh * 128,
                                         SG + qrow0 * 2048 + h * 128, H + qrow0 * 2048 + h * 128, seq, (char*)lds_raw);
                }
                { pg8::Gemm g{(const bf16_t*)(ws + WS_DFTL), ABT, 4096, 4096, 4096, 0, (long)512 * 4096}; pg8::StaticOrder S; S.init(8, 2, 8, G, (bx + 128) % G);
                  EpiDft E{H, SG, 0, SEQ, 1.0f / 512.0f}; pg8::gemm_phase<EpiDft>(lds, g, S, E); }
                if (l == 0) { pg8::Gemm g{(const bf16_t*)(ws + WS_DFTC), ABTC, 512, 512, 512, 0, (long)512 * 512}; pg8::StaticOrder S; S.init(1, 2, 8, G, (bx + 64) % G);
                  EpiDft E{H, SG, ML, CTXL, 0.005524271728019903f}; pg8::gemm_phase<EpiDft>(lds, g, S, E); }
                phase_pool(a, l, vcu, G);
            }
            else {
                pg8::Gemm g{H, WOUTT, 2048, 2048, 2048, 0, 0}; pg8::StaticOrder S; S.init((l == 0 ? MT : ML) / 256, 8, 1, G, bx);
                EpiOut E{l == 0 ? a.x : a.out, a.ctx, a.out, (float*)(ws + WS_XC1), (const float*)(ws + WS_MOD) + (size_t)l * 9 * 6144};
                pg8::gemm_phase<EpiOut>(lds, g, S, E);
            }
        }
        if (ph + 1 < a.ph_hi) cg::this_grid().sync();
    }
}

extern "C" void kernel_launch(void* const* d_in, const int* in_sizes, int n_in, void* d_out, int out_size, void* d_ws, size_t ws_size, hipStream_t stream) {
    static int grid = 0;
    if (grid == 0) {
        if (n_in != 15 || out_size != ML * DM || ws_size < WS_END) { fprintf(stderr, "kernel_launch: unexpected shapes (n_in %d out %d ws %zu)\n", n_in, out_size, ws_size); grid = -1; return; }
        int dev = 0, cus = 0, per_cu = 0;
        hipGetDevice(&dev); hipDeviceGetAttribute(&cus, hipDeviceAttributeMultiprocessorCount, dev);
        if (hipFuncSetAttribute((const void*)mega_fwd, hipFuncAttributeMaxDynamicSharedMemorySize, LDS_BYTES) != hipSuccess) { fprintf(stderr, "kernel_launch: hipFuncSetAttribute failed\n"); grid = -1; return; }
        if (hipOccupancyMaxActiveBlocksPerMultiprocessor(&per_cu, (const void*)mega_fwd, NTHR, LDS_BYTES) != hipSuccess || per_cu < 1) { fprintf(stderr, "kernel_launch: occupancy query failed (%d)\n", per_cu); per_cu = 1; }
        (void)hipGetLastError();
        grid = cus * (per_cu > 1 ? 1 : per_cu);
        fprintf(stderr, "kernel_launch: grid %d (cus %d, per_cu %d)\n", grid, cus, per_cu);
    }
    if (grid < 0) return;
    Args a{};
    a.x = (const float*)d_in[0]; a.c = (const float*)d_in[1]; a.ctx = (const float*)d_in[2]; a.c_ctx = (const float*)d_in[3];
    a.ada_w = (const float*)d_in[4]; a.ada_b = (const float*)d_in[5]; a.norm_g = (const float*)d_in[6]; a.w_in = (const float*)d_in[7];
    a.q_norm_g = (const float*)d_in[8]; a.k_norm_g = (const float*)d_in[9]; a.pool_w = (const float*)d_in[10]; a.pool_scale = (const float*)d_in[11];
    a.fourier_w = (const float*)d_in[12]; a.w_out = (const float*)d_in[13]; a.final_norm_g = (const float*)d_in[14];
    a.out = (float*)d_out; a.ws = (unsigned char*)d_ws;
#if MK_MULTI
    for (int ph = 0; ph < N_PHASES; ++ph) { a.ph_lo = ph; a.ph_hi = ph + 1; hipLaunchKernelGGL(mega_fwd, dim3(grid), dim3(NTHR), LDS_BYTES, stream, a); }
#else
    a.ph_lo = 0; a.ph_hi = N_PHASES;
    void* args[] = {&a};
    hipError_t e = hipLaunchCooperativeKernel((const void*)mega_fwd, dim3(grid), dim3(NTHR), args, LDS_BYTES, stream);
    if (e != hipSuccess) fprintf(stderr, "kernel_launch: cooperative launch failed: %s (grid %d)\n", hipGetErrorString(e), grid);
#endif
}
```

```cpp
#include <hip/hip_runtime.h>
#include <hip/hip_cooperative_groups.h>
#include <hip/hip_bf16.h>
#include <cstdio>
#include <cstdint>
namespace cg = cooperative_groups;

#ifndef MK_MULTI
#define MK_MULTI 0
#endif

constexpr int DM = 2048, NB = 8, SEQ = 2048, CTXL = 256, DEPTH = 2;
constexpr int ML = NB * SEQ, MC = NB * CTXL, MT = ML + MC, SKV = SEQ + CTXL;
constexpr int INW = 4608, OFFP = 1536, OFFF = 2048, OFFG = 2560;
constexpr float EPS = 1e-6f;
constexpr int NWAVES = 8, NTHR = 512;

constexpr size_t MiB = 1u << 20;
constexpr size_t WS_CTL = 0;
constexpr size_t WS_MODP = 1 * MiB;
constexpr size_t WS_MOD = 16 * MiB;
constexpr size_t WS_ROPE = 16 * MiB + 512 * 1024;
constexpr size_t WS_MFOLD = 17 * MiB;
constexpr size_t WS_WINT = 18 * MiB;
constexpr size_t WS_WFT = 50 * MiB;
constexpr size_t WS_WOUTT = 58 * MiB;
constexpr size_t WS_DFTL = 74 * MiB;
constexpr size_t WS_DFTC = 90 * MiB;
constexpr size_t WS_H = 91 * MiB;
constexpr size_t WS_QB = 163 * MiB;
constexpr size_t WS_KRAW = 199 * MiB;
constexpr size_t WS_KB = 208 * MiB;
constexpr size_t WS_VB = 217 * MiB;
constexpr size_t WS_UPW = 226 * MiB;
constexpr size_t WS_SG = 244 * MiB;
constexpr size_t WS_ABT = 316 * MiB;
constexpr size_t WS_ABTC = 348 * MiB;
constexpr size_t WS_XC1 = 352 * MiB;
constexpr size_t WS_AEBO = 368 * MiB;
constexpr size_t WS_NYQ = 384 * MiB;
constexpr size_t WS_END = 385 * MiB;

constexpr int RING_BYTES = 131072;
constexpr int OST_OFF = 66 * 1024;
constexpr int MISC_OFF = 132 * 1024;
constexpr int LDS_BYTES = 136 * 1024;

#define LAS __attribute__((address_space(3)))
typedef unsigned short bf16_t;
typedef short bf16x8 __attribute__((ext_vector_type(8)));
typedef float f32x4 __attribute__((ext_vector_type(4)));
typedef float f32x16 __attribute__((ext_vector_type(16)));
typedef short s16x4 __attribute__((ext_vector_type(4)));
typedef unsigned u32x4 __attribute__((ext_vector_type(4)));
typedef unsigned u32x2 __attribute__((ext_vector_type(2)));

__device__ __forceinline__ int opaque_tid() { int t = threadIdx.x; asm volatile("" : "+v"(t)); return t; }
template <class T> __device__ __forceinline__ T* opaque_ptr(T* p) { int z = 0; asm volatile("" : "+s"(z)); return p + z; }
__device__ __forceinline__ unsigned f2bf(float f) { unsigned u = __builtin_bit_cast(unsigned, f); return (u + 0x7fffu + ((u >> 16) & 1u)) >> 16; }
typedef float f32x2_t __attribute__((ext_vector_type(2))); typedef __bf16 bf16x2_t __attribute__((ext_vector_type(2)));
__device__ __forceinline__ unsigned pk2(float lo, float hi) { f32x2_t v = {lo, hi}; bf16x2_t b = __builtin_convertvector(v, bf16x2_t); return __builtin_bit_cast(unsigned, b); }
__device__ __forceinline__ float bf_lo(unsigned w) { return __builtin_bit_cast(float, w << 16); }
__device__ __forceinline__ float bf_hi(unsigned w) { return __builtin_bit_cast(float, w & 0xffff0000u); }
__device__ __forceinline__ float bf2f(bf16_t h) { return __builtin_bit_cast(float, (unsigned)h << 16); }
__device__ __forceinline__ unsigned cvt_pk_bf16(float lo, float hi) { return pk2(lo, hi); }
__device__ __forceinline__ float silu_f(float x) { return x / (1.0f + __expf(-x)); }
__device__ __forceinline__ float wave_sum(float v) {
#pragma unroll
    for (int o = 1; o < 64; o <<= 1) v += __shfl_xor(v, o);
    return v;
}
__device__ __forceinline__ int kvrow(int grow) {
    if (grow < ML) return (grow >> 11) * SKV + CTXL + (grow & 2047);
    const int rc = grow - ML; return (rc >> 8) * SKV + (rc & 255);
}

namespace pg8 {
constexpr int BM = 256, BK = 64, HALF = 128, HTB = HALF * BK * 2, NXCD = 8, WGM = 8;
__host__ __device__ __forceinline__ int lds_byte(int r, int c) { const int st = (r >> 4) * 2 + (c >> 5), rr = r & 15, cc = c & 31, ob = rr * 64 + cc * 2; return st * 1024 + (ob ^ (((ob >> 9) & 1) << 5)); }
__host__ __device__ __forceinline__ void stage_rc(int b, int& R, int& C) { const int st = b / 1024, sb = b % 1024, swz = sb ^ (((sb >> 9) & 1) << 5); R = (st >> 1) * 16 + swz / 64; C = (st & 1) * 32 + (swz % 64) / 2; }
__host__ __device__ __forceinline__ int perm32(int rho) { const int n = rho >> 4, i = rho & 15; return 8 * (i >> 2) + 4 * n + (i & 3); }

struct Unit { int pm, pn, z; };
struct Gemm { const bf16_t* A; const bf16_t* Bt; int lda, ldb, K; long tA, hA, tB, hB, zA, zB; };
__device__ __forceinline__ Gemm make_gemm(const bf16_t* A, const bf16_t* Bt, int lda, int ldb, int K, long zA = 0, long zB = 0) { return Gemm{A, Bt, lda, ldb, K, 256L * lda, 128L * lda, 256L * ldb, 128L * ldb, zA, zB}; }

struct StaticOrder {
    int nM, nN, nMN, nwg, G, c;
    __device__ void init(int nM_, int nN_, int nZ_, int G_, int c_) { nM = nM_; nN = nN_; nMN = nM_ * nN_; nwg = nMN * nZ_; G = G_; c = c_; }
    __device__ bool next(int i, Unit& u) const {
        const long L = (long)i * G + c; if (L >= nwg) return false;
        int wgid = (int)L; { const int q = nwg / NXCD, r = nwg % NXCD, xcd = wgid % NXCD, off = wgid / NXCD; wgid = (xcd < r ? xcd * (q + 1) : r * (q + 1) + (xcd - r) * q) + off; }
        u.z = wgid / nMN; wgid -= u.z * nMN;
        const int nig = WGM * nN, gid = wgid / nig, fm = gid * WGM, gsz = (nM - fm) < WGM ? (nM - fm) : WGM;
        u.pm = fm + ((wgid % nig) % gsz); u.pn = (wgid % nig) / gsz; return true;
    }
};

template <class Epi>
__device__ __forceinline__ void gemm_phase(LAS unsigned char* lds, const Gemm g, const StaticOrder& S, const Epi& E) {
    const int tid = opaque_tid(), wid = __builtin_amdgcn_readfirstlane(tid >> 6), lane = tid & 63, wr = wid >> 2, wc = wid & 3, fr = lane & 15, fq = lane >> 4;
    const int K = g.K, nt = K / BK;
    unsigned voffA[2], voffB[2];
#pragma unroll
    for (int i = 0; i < 2; ++i) { int R, C; stage_rc(tid * 16 + i * 8192, R, C); const int Rb = Epi::PERM ? ((R & ~31) + perm32(R & 31)) : R;
        voffA[i] = (unsigned)(R * g.lda + C) * 2u; voffB[i] = (unsigned)(Rb * g.ldb + C) * 2u; }
    const size_t kstep = (size_t)(BK * 2);
    const size_t hstepA = (size_t)g.hA * 2, hstepB = (size_t)g.hB * 2;
    const unsigned ldsw = (unsigned)wid * 1024u;
    const int aoff = lds_byte(wr * 64 + fr, fq * 8), boff = lds_byte(wc * 32 + fr, fq * 8);
#define PG8_SA(b, h) (((b) * 2 + (h)) * HTB)
#define PG8_SB(b, h) ((4 + (b) * 2 + (h)) * HTB)
#define PG8_STAGE(bufoff, gbase, voff) do { _Pragma("unroll") for (int _i = 0; _i < 2; ++_i) \
        __builtin_amdgcn_global_load_lds((const unsigned*)((const char*)(gbase) + (voff)[_i]), (LAS unsigned*)(lds + (bufoff) + ldsw + _i * 8192), 16, 0, 0); } while (0)
#define PG8_LDA(dst, b, h) do { _Pragma("unroll") for (int m = 0; m < 4; ++m) _Pragma("unroll") for (int k = 0; k < 2; ++k) dst[m][k] = *(const LAS bf16x8*)(lds + PG8_SA(b, h) + aoff + m * 2048 + k * 1024); } while (0)
#define PG8_LDB(dst, b, h) do { _Pragma("unroll") for (int n = 0; n < 2; ++n) _Pragma("unroll") for (int k = 0; k < 2; ++k) dst[n][k] = *(const LAS bf16x8*)(lds + PG8_SB(b, h) + boff + n * 2048 + k * 1024); } while (0)
#define PG8_MMA(ai, bj, At, Bt) do { __builtin_amdgcn_s_setprio(1); _Pragma("unroll") for (int m = 0; m < 4; ++m) _Pragma("unroll") for (int n = 0; n < 2; ++n) _Pragma("unroll") for (int k = 0; k < 2; ++k) \
        acc[ai][bj][m][n] = __builtin_amdgcn_mfma_f32_16x16x32_bf16(Bt[n][k], At[m][k], acc[ai][bj][m][n], 0, 0, 0); __builtin_amdgcn_s_setprio(0); } while (0)
#define PG8_WAIT_V(n) asm volatile("s_waitcnt vmcnt(" #n ")" ::: "memory")
#define PG8_WAIT_L(n) asm volatile("s_waitcnt lgkmcnt(" #n ")" ::: "memory")
#define PG8_BAR __builtin_amdgcn_s_barrier()
#define PG8_SCHED __builtin_amdgcn_sched_barrier(0)
    Unit cur, nxt; int ui = 0;
    if (!S.next(0, cur)) return;
    f32x4 acc[2][2][4][2];
#pragma unroll
    for (int a = 0; a < 2; ++a)
#pragma unroll
        for (int b = 0; b < 2; ++b)
#pragma unroll
            for (int m = 0; m < 4; ++m)
#pragma unroll
                for (int n = 0; n < 2; ++n) acc[a][b][m][n] = (f32x4){0.f, 0.f, 0.f, 0.f};
    bf16x8 At[4][2], B0[2][2], B1[2][2];
    const char* cA = (const char*)g.A + ((size_t)cur.z * g.zA + (size_t)cur.pm * g.tA) * 2;
    const char* cB = (const char*)g.Bt + ((size_t)cur.z * g.zB + (size_t)cur.pn * g.tB) * 2;
    PG8_STAGE(PG8_SB(0, 0), cB, voffB); PG8_STAGE(PG8_SB(0, 1), cB + hstepB, voffB); PG8_STAGE(PG8_SA(0, 0), cA, voffA); PG8_STAGE(PG8_SA(0, 1), cA + hstepA, voffA);
    if (wr == 1) PG8_BAR;
    PG8_WAIT_V(2); PG8_BAR;
    PG8_STAGE(PG8_SB(1, 0), cB + kstep, voffB); PG8_STAGE(PG8_SA(1, 0), cA + kstep, voffA); PG8_STAGE(PG8_SB(1, 1), cB + hstepB + kstep, voffB);
    PG8_WAIT_V(6); PG8_BAR;
    for (;;) {
        const bool has_next = S.next(ui + 1, nxt);
        const char* nA = has_next ? (const char*)g.A + ((size_t)nxt.z * g.zA + (size_t)nxt.pm * g.tA) * 2 : cA;
        const char* nB = has_next ? (const char*)g.Bt + ((size_t)nxt.z * g.zB + (size_t)nxt.pn * g.tB) * 2 : cB;
        for (int t = 0; t < nt; t += 2) {
            const bool last = (t == nt - 2);
            const char* a1 = cA + (size_t)(t + 1) * kstep;
            const char* a2 = last ? nA : cA + (size_t)(t + 2) * kstep; const char* b2 = last ? nB : cB + (size_t)(t + 2) * kstep;
            const char* a3 = a2 + kstep; const char* b3 = b2 + kstep;
            PG8_LDB(B0, 0, 0); PG8_LDB(B1, 0, 1); PG8_SCHED; PG8_LDA(At, 0, 0); PG8_STAGE(PG8_SA(1, 1), a1 + hstepA, voffA);
            PG8_WAIT_V(8); PG8_WAIT_L(0); PG8_BAR; PG8_MMA(0, 0, At, B0); PG8_MMA(0, 1, At, B1); PG8_BAR; PG8_SCHED;
            PG8_LDA(At, 0, 1); PG8_STAGE(PG8_SB(0, 0), b2, voffB); PG8_STAGE(PG8_SB(0, 1), b2 + hstepB, voffB); PG8_STAGE(PG8_SA(0, 0), a2, voffA);
            PG8_WAIT_V(8); PG8_WAIT_L(0); PG8_BAR; PG8_MMA(1, 0, At, B0); PG8_MMA(1, 1, At, B1); PG8_BAR; PG8_SCHED;
            PG8_LDB(B0, 1, 0); PG8_LDB(B1, 1, 1); PG8_SCHED; PG8_LDA(At, 1, 0); PG8_STAGE(PG8_SA(0, 1), a2 + hstepA, voffA);
            PG8_WAIT_V(8); PG8_WAIT_L(0); PG8_BAR; PG8_MMA(0, 0, At, B0); PG8_MMA(0, 1, At, B1); PG8_BAR; PG8_SCHED;
            PG8_LDA(At, 1, 1); PG8_STAGE(PG8_SB(1, 0), b3, voffB); PG8_STAGE(PG8_SB(1, 1), b3 + hstepB, voffB); PG8_STAGE(PG8_SA(1, 0), a3, voffA);
            PG8_WAIT_V(8); PG8_WAIT_L(0); PG8_BAR; PG8_MMA(1, 0, At, B0); PG8_MMA(1, 1, At, B1); PG8_BAR; PG8_SCHED;
        }
        if (wr == 0) PG8_BAR;
        E(acc, cur, wr, wc, fr, fq);
        if (!has_next) break;
#pragma unroll
        for (int a = 0; a < 2; ++a)
#pragma unroll
            for (int b = 0; b < 2; ++b)
#pragma unroll
                for (int m = 0; m < 4; ++m)
#pragma unroll
                    for (int n = 0; n < 2; ++n) acc[a][b][m][n] = (f32x4){0.f, 0.f, 0.f, 0.f};
        cur = nxt; cA = nA; cB = nB; ++ui;
        if (wr == 1) PG8_BAR;
    }
    PG8_WAIT_V(0);
    PG8_BAR;
#undef PG8_SA
#undef PG8_SB
#undef PG8_STAGE
#undef PG8_LDA
#undef PG8_LDB
#undef PG8_MMA
#undef PG8_WAIT_V
#undef PG8_WAIT_L
#undef PG8_BAR
#undef PG8_SCHED
}
}

typedef const f32x4 (&AccRef)[2][2][4][2];
struct EpiInProj {
    static constexpr bool PERM = true;
    bf16_t *QB, *KRAW, *VB, *UPW, *SG; int row_off, pn_base;
    __device__ __forceinline__ void operator()(AccRef acc, const pg8::Unit& u, int wr, int wc, int fr, int fq) const {
        const int pn = u.pn + pn_base;
        bf16_t* base; int ld, ccol; bool act = false, kvmap = false;
        if (pn < 4) { base = QB; ld = 1024; ccol = pn * 256; }
        else if (pn == 4) { base = KRAW; ld = 256; ccol = 0; }
        else if (pn == 5) { base = VB; ld = 256; ccol = 0; kvmap = true; }
        else if (pn < 8) { base = UPW; ld = 512; ccol = (pn - 6) * 256; }
        else { base = SG; ld = 2048; ccol = (pn - 8) * 256; act = true; }
        const int row0 = row_off + u.pm * 256 + wr * 64 + fr, col0 = ccol + wc * 32 + 8 * fq;
#pragma unroll
        for (int ai = 0; ai < 2; ++ai)
#pragma unroll
            for (int m = 0; m < 4; ++m) {
                const int grow = row0 + ai * 128 + m * 16; const int drow = kvmap ? kvrow(grow) : grow;
                bf16_t* rowp = base + (size_t)drow * ld + col0;
#pragma unroll
                for (int bj = 0; bj < 2; ++bj) { f32x4 v0 = acc[ai][bj][m][0], v1 = acc[ai][bj][m][1];
                    if (act) {
#pragma unroll
                        for (int e = 0; e < 4; ++e) { v0[e] = silu_f(v0[e]); v1[e] = silu_f(v1[e]); } }
                    u32x4 w; w.x = cvt_pk_bf16(v0[0], v0[1]); w.y = cvt_pk_bf16(v0[2], v0[3]); w.z = cvt_pk_bf16(v1[0], v1[1]); w.w = cvt_pk_bf16(v1[2], v1[3]);
                    *(u32x4*)(rowp + bj * 128) = w; } }
    }
};
struct EpiFourT {
    static constexpr bool PERM = true;
    bf16_t *ABT, *ABTC;
    __device__ __forceinline__ void operator()(AccRef acc, const pg8::Unit& u, int wr, int wc, int fr, int fq) const {
        const int tok0 = u.pn * 256;
        bf16_t* base; int nlen, n0, b;
        if (tok0 < ML) { b = tok0 >> 11; n0 = tok0 & 2047; nlen = SEQ; base = ABT; }
        else { const int tc = tok0 - ML; b = tc >> 8; n0 = 0; nlen = CTXL; base = ABTC; }
        const int row0 = u.pm * 256 + wr * 64 + fr, col0 = n0 + wc * 32 + 8 * fq;
#pragma unroll
        for (int ai = 0; ai < 2; ++ai)
#pragma unroll
            for (int m = 0; m < 4; ++m) {
                const int row = row0 + ai * 128 + m * 16, part = row >> 9, ch = row & 511;
                bf16_t* rowp = base + (((size_t)b * 512 + ch) * 2 + part) * nlen + col0;
#pragma unroll
                for (int bj = 0; bj < 2; ++bj) { const f32x4 v0 = acc[ai][bj][m][0], v1 = acc[ai][bj][m][1];
                    u32x4 w; w.x = cvt_pk_bf16(v0[0], v0[1]); w.y = cvt_pk_bf16(v0[2], v0[3]); w.z = cvt_pk_bf16(v1[0], v1[1]); w.w = cvt_pk_bf16(v1[2], v1[3]);
                    *(u32x4*)(rowp + bj * 128) = w; } }
    }
};
struct EpiDft {
    static constexpr bool PERM = true;
    bf16_t* MIX; const bf16_t* SG; int row_base, rows_per_z; float norm;
    __device__ __forceinline__ void operator()(AccRef acc, const pg8::Unit& u, int wr, int wc, int fr, int fq) const {
        const int row0 = row_base + u.z * rows_per_z + u.pm * 256 + wr * 64 + fr, col0 = 1536 + u.pn * 256 + wc * 32 + 8 * fq;
#pragma unroll
        for (int ai = 0; ai < 2; ++ai) {
            u32x4 sg[4][2];
#pragma unroll
            for (int m = 0; m < 4; ++m)
#pragma unroll
                for (int bj = 0; bj < 2; ++bj) sg[m][bj] = *(const u32x4*)(SG + (size_t)(row0 + ai * 128 + m * 16) * 2048 + col0 + bj * 128);
#pragma unroll
            for (int m = 0; m < 4; ++m) {
                const size_t off = (size_t)(row0 + ai * 128 + m * 16) * 2048 + col0;
#pragma unroll
                for (int bj = 0; bj < 2; ++bj) { const f32x4 v0 = acc[ai][bj][m][0] * norm, v1 = acc[ai][bj][m][1] * norm;
                    const u32x4 s = sg[m][bj];
                    u32x4 w; w.x = cvt_pk_bf16(v0[0] * bf_lo(s.x), v0[1] * bf_hi(s.x)); w.y = cvt_pk_bf16(v0[2] * bf_lo(s.y), v0[3] * bf_hi(s.y));
                    w.z = cvt_pk_bf16(v1[0] * bf_lo(s.z), v1[1] * bf_hi(s.z)); w.w = cvt_pk_bf16(v1[2] * bf_lo(s.w), v1[3] * bf_hi(s.w));
                    *(u32x4*)(MIX + off + bj * 128) = w; } }
            asm volatile("" ::: "memory");
        }
    }
};
struct EpiDftF {
    static constexpr bool PERM = true;
    bf16_t* MIX; const bf16_t* SG; const float* NYQ; float norm;
    __device__ __forceinline__ void gate_store(size_t off, f32x4 v0, f32x4 v1) const {
        const u32x4 s = *(const u32x4*)(SG + off);
        u32x4 w; w.x = cvt_pk_bf16(v0[0] * bf_lo(s.x), v0[1] * bf_hi(s.x)); w.y = cvt_pk_bf16(v0[2] * bf_lo(s.y), v0[3] * bf_hi(s.y));
        w.z = cvt_pk_bf16(v1[0] * bf_lo(s.z), v1[1] * bf_hi(s.z)); w.w = cvt_pk_bf16(v1[2] * bf_lo(s.w), v1[3] * bf_hi(s.w));
        *(u32x4*)(MIX + off) = w;
    }
    __device__ __forceinline__ void operator()(AccRef acc, const pg8::Unit& u, int wr, int wc, int fr, int fq) const {
        const int b = u.z, ch0 = u.pn * 128 + wc * 32 + 8 * fq, kb = u.pm * 128 + wr * 64 + fr;
        const f32x4 t0 = *(const f32x4*)(NYQ + b * 512 + ch0), t1 = *(const f32x4*)(NYQ + b * 512 + ch0 + 4);
#pragma unroll
        for (int m = 0; m < 4; ++m) {
            const int k = kb + m * 16; const float sgn = (k & 1) ? -1.0f : 1.0f;
            const f32x4 P0 = acc[0][0][m][0] + t0 * sgn, P1 = acc[0][0][m][1] + t1 * sgn, Q0 = acc[1][1][m][0], Q1 = acc[1][1][m][1];
            gate_store((size_t)(b * SEQ + k) * 2048 + 1536 + ch0, (P0 - Q0) * norm, (P1 - Q1) * norm);
            if (k > 0) gate_store((size_t)(b * SEQ + SEQ - k) * 2048 + 1536 + ch0, (P0 + Q0) * norm, (P1 + Q1) * norm);
        }
    }
};
struct EpiOut {
    static constexpr bool PERM = false;
    const float* xsrc; const float* csrc; float* xdst; float* cdst; const float* mod;
    __device__ __forceinline__ void operator()(AccRef acc, const pg8::Unit& u, int wr, int wc, int fr, int fq) const {
        const int rowt = u.pm * 256; const bool lat = rowt < ML;
        const int modrow = lat ? (rowt >> 11) : 8;
        const float* src = lat ? xsrc + (size_t)rowt * 2048 : csrc + (size_t)(rowt - ML) * 2048;
        float* dst = lat ? xdst + (size_t)rowt * 2048 : cdst + (size_t)(rowt - ML) * 2048;
        const int col0 = u.pn * 256 + wc * 32 + 4 * fq;
        f32x4 gv[2][2];
#pragma unroll
        for (int bj = 0; bj < 2; ++bj)
#pragma unroll
            for (int n = 0; n < 2; ++n) gv[bj][n] = *(const f32x4*)(mod + (size_t)modrow * 6144 + 4096 + col0 + bj * 128 + n * 16);
#pragma unroll
        for (int ai = 0; ai < 2; ++ai)
#pragma unroll
            for (int m = 0; m < 4; ++m) { const size_t off = (size_t)(ai * 128 + wr * 64 + m * 16 + fr) * 2048 + col0;
#pragma unroll
                for (int bj = 0; bj < 2; ++bj)
#pragma unroll
                    for (int n = 0; n < 2; ++n) { const f32x4 xi = *(const f32x4*)(src + off + bj * 128 + n * 16);
                        *(f32x4*)(dst + off + bj * 128 + n * 16) = xi + gv[bj][n] * acc[ai][bj][m][n]; }
                if (m & 1) asm volatile("" ::: "memory"); }
    }
};

namespace att {
constexpr int D = 128, QBLK = 32, KVBLK = 64, LDQ = 1024, LDK = 256, LDO = 2048;
constexpr float SCALE = 0.088388347648318440f, THR = 8.f;
constexpr size_t SHM_V = KVBLK * D * 2, SHM_K = KVBLK * D * 2;
#define KSWZ(row, colB) ((row) * 256 + ((colB) ^ (((row) & 7) << 4)))
#define SBAR() __builtin_amdgcn_sched_barrier(0)
__device__ __forceinline__ int crow(int r, int hi) { return (r & 3) + 8 * (r >> 2) + 4 * hi; }
__device__ __forceinline__ unsigned cvtpk(float lo, float hi) { unsigned r; asm volatile("v_cvt_pk_bf16_f32 %0, %1, %2" : "=v"(r) : "v"(lo), "v"(hi)); return r; }
__device__ __forceinline__ void partialSM(f32x16& p0, f32x16& p1, float& m_reg, float& mn, float& alpha) {
  constexpr float C = SCALE * 1.4426950408889634f;
  float pmax = p0[0]; for (int r = 1; r < 16; ++r) pmax = fmaxf(pmax, p0[r]); for (int r = 0; r < 16; ++r) pmax = fmaxf(pmax, p1[r]);
  { auto rr = __builtin_amdgcn_permlane32_swap(__float_as_uint(pmax), __float_as_uint(pmax), false, false);
    pmax = fmaxf(__uint_as_float(rr[0]), __uint_as_float(rr[1])); }
  if (__builtin_expect(__all(pmax - m_reg <= THR / SCALE), 1)) { mn = m_reg; alpha = 1.f; }
  else { mn = fmaxf(m_reg, pmax); alpha = __builtin_amdgcn_exp2f((m_reg - mn) * C); m_reg = mn; }
  float mnC = -mn * C;
  for (int r = 0; r < 16; ++r) p0[r] = fmaf(p0[r], C, mnC); for (int r = 0; r < 16; ++r) p1[r] = fmaf(p1[r], C, mnC);
  for (int r = 0; r < 16; ++r) p0[r] = __builtin_amdgcn_exp2f(p0[r]);
}
__device__ __forceinline__ void finishSM(f32x16& p0, f32x16& p1, float alpha, float& l_reg, bf16x8& pa0, bf16x8& pa1, bf16x8& pa2, bf16x8& pa3) {
  for (int r = 0; r < 16; ++r) p1[r] = __builtin_amdgcn_exp2f(p1[r]);
  float ps = 0; for (int r = 0; r < 16; ++r) ps += p0[r]; for (int r = 0; r < 16; ++r) ps += p1[r];
  { auto rr = __builtin_amdgcn_permlane32_swap(__float_as_uint(ps), __float_as_uint(ps), false, false);
    ps = __uint_as_float(rr[0]) + __uint_as_float(rr[1]); }
  l_reg = l_reg * alpha + ps;
#define PK4(P, BASE, OUT) do { unsigned a0 = cvtpk(P[BASE + 0], P[BASE + 1]), a1 = cvtpk(P[BASE + 2], P[BASE + 3]);   \
    unsigned b0 = cvtpk(P[BASE + 4], P[BASE + 5]), b1 = cvtpk(P[BASE + 6], P[BASE + 7]);                              \
    auto r0 = __builtin_amdgcn_permlane32_swap(a0, b0, false, false); auto r1 = __builtin_amdgcn_permlane32_swap(a1, b1, false, false); \
    u32x4 w = {r0[0], r1[0], r0[1], r1[1]}; OUT = *reinterpret_cast<bf16x8*>(&w); } while (0)
  PK4(p0, 0, pa0); PK4(p0, 8, pa1); PK4(p1, 0, pa2); PK4(p1, 8, pa3);
#undef PK4
}
__device__ __forceinline__ void qkt(f32x16& p0, f32x16& p1, const bf16_t* Ks, const bf16x8* qr, int r32, int hi) {
  p0 = f32x16{}; p1 = f32x16{};
  for (int d0 = 0; d0 < 8; ++d0) { int cb = (d0 * 16 + hi * 8) * 2;
    bf16x8 b0 = *reinterpret_cast<const bf16x8*>((const char*)Ks + KSWZ(r32, cb));
    bf16x8 b1 = *reinterpret_cast<const bf16x8*>((const char*)Ks + KSWZ(32 + r32, cb));
    p0 = __builtin_amdgcn_mfma_f32_32x32x16_bf16(b0, qr[d0], p0, 0, 0, 0);
    p1 = __builtin_amdgcn_mfma_f32_32x32x16_bf16(b1, qr[d0], p1, 0, 0, 0); }
}
__device__ __forceinline__ int v_st(int k, int c) { const int kk = (k & ~0xC) | ((k & 4) << 1) | ((k & 8) >> 1); return ((kk >> 3) * 4 + (c >> 5)) * 512 + ((kk & 7) * 32 + (c & 31)) * 2; }
__device__ __forceinline__ int v_rd_base(int lane) { return ((lane & 3) << 3) | (((lane >> 2) & 3) << 6) | (((lane >> 4) & 1) << 5) | (((lane >> 5) & 1) << 8); }
constexpr int v_rd_off(int d0, int ks, int half) { return d0 * 512 + ks * 4096 + half * 2048; }
template <int OFF> __device__ __forceinline__ s16x4 tr_read(int vb) {
  s16x4 r; asm volatile("ds_read_b64_tr_b16 %0, %1 offset:%2" : "=&v"(r) : "v"(vb), "i"(OFF) : "memory"); return r;
}
template <int D0> __device__ __forceinline__ void pv_one(f32x16& od, int vb, bf16x8 pa0, bf16x8 pa1, bf16x8 pa2, bf16x8 pa3) {
  const s16x4 l0 = tr_read<v_rd_off(D0, 0, 0)>(vb), h0 = tr_read<v_rd_off(D0, 0, 1)>(vb), l1 = tr_read<v_rd_off(D0, 1, 0)>(vb), h1 = tr_read<v_rd_off(D0, 1, 1)>(vb);
  const s16x4 l2 = tr_read<v_rd_off(D0, 2, 0)>(vb), h2 = tr_read<v_rd_off(D0, 2, 1)>(vb), l3 = tr_read<v_rd_off(D0, 3, 0)>(vb), h3 = tr_read<v_rd_off(D0, 3, 1)>(vb);
  asm volatile("s_waitcnt lgkmcnt(0)" ::: "memory"); SBAR();
#define PK(L, H) (bf16x8){L[0], L[1], L[2], L[3], H[0], H[1], H[2], H[3]}
  od = __builtin_amdgcn_mfma_f32_32x32x16_bf16(pa0, PK(l0, h0), od, 0, 0, 0);
  od = __builtin_amdgcn_mfma_f32_32x32x16_bf16(pa1, PK(l1, h1), od, 0, 0, 0);
  od = __builtin_amdgcn_mfma_f32_32x32x16_bf16(pa2, PK(l2, h2), od, 0, 0, 0);
  od = __builtin_amdgcn_mfma_f32_32x32x16_bf16(pa3, PK(l3, h3), od, 0, 0, 0);
#undef PK
}
__device__ __forceinline__ void pv_d0(f32x16* o, int vb, bf16x8 pa0, bf16x8 pa1, bf16x8 pa2, bf16x8 pa3) {
  pv_one<0>(o[0], vb, pa0, pa1, pa2, pa3); pv_one<1>(o[1], vb, pa0, pa1, pa2, pa3); pv_one<2>(o[2], vb, pa0, pa1, pa2, pa3); pv_one<3>(o[3], vb, pa0, pa1, pa2, pa3);
}
__device__ __forceinline__ void attn_dense_body(const bf16_t* __restrict__ Qb, const bf16_t* __restrict__ Kh, const bf16_t* __restrict__ Vh,
                                                const bf16_t* __restrict__ Gb, bf16_t* __restrict__ Mb, int seq, char* lds) {
  const int tid = opaque_tid(), wid = tid >> 6, lane = tid & 63, r32 = lane & 31, hi = lane >> 5;
  bf16_t* V_lds = (bf16_t*)lds; bf16_t* K_lds = (bf16_t*)(lds + 2 * SHM_V);
  float* ws = (float*)(lds + 2 * SHM_V + 2 * SHM_K) + wid * 64; float* li_l = ws; float* al_l = ws + 32;
  float m_reg = -1e30f, l_reg = 0; f32x16 o[4] = {}; bf16x8 qr[8];
  const bf16_t* Qw = Qb + (long)(wid * QBLK + r32) * LDQ + hi * 8;
#pragma unroll
  for (int d0 = 0; d0 < 8; ++d0) qr[d0] = *reinterpret_cast<const bf16x8*>(Qw + d0 * 16);
  const int sr = tid >> 4, sc = (tid & 15) * 8, vst0 = v_st(sr, sc), vst1 = v_st(32 + sr, sc);
  const int vb0 = (int)(uintptr_t)V_lds + v_rd_base(lane);
  struct { bf16x8 vs0, vs1, ks0, ks1; } sr_[2];
#define SLOAD(i, k0) do { sr_[i].vs0 = *reinterpret_cast<const bf16x8*>(&Vh[(long)((k0) + sr) * LDK + sc]); sr_[i].vs1 = *reinterpret_cast<const bf16x8*>(&Vh[(long)((k0) + 32 + sr) * LDK + sc]); \
    sr_[i].ks0 = *reinterpret_cast<const bf16x8*>(&Kh[(long)((k0) + sr) * LDK + sc]); sr_[i].ks1 = *reinterpret_cast<const bf16x8*>(&Kh[(long)((k0) + 32 + sr) * LDK + sc]); } while (0)
#define SWRITE(b, i) do { *(bf16x8*)((char*)V_lds + (b) * SHM_V + vst0) = sr_[i].vs0;          \
    *(bf16x8*)((char*)V_lds + (b) * SHM_V + vst1) = sr_[i].vs1; int kc = sc * 2;               \
    *(bf16x8*)((char*)K_lds + (b) * SHM_K + KSWZ(sr, kc)) = sr_[i].ks0;                       \
    *(bf16x8*)((char*)K_lds + (b) * SHM_K + KSWZ(32 + sr, kc)) = sr_[i].ks1; } while (0)
#define SWAIT() asm volatile("s_waitcnt vmcnt(4)" ::: "memory")
#define RESC(a) do { if (__any((a) < 1.f)) { if (hi == 0) al_l[r32] = (a); asm volatile("s_waitcnt lgkmcnt(0)" ::: "memory"); \
    for (int d = 0; d < 4; ++d) for (int r = 0; r < 16; ++r) o[d][r] *= al_l[crow(r, hi)]; } } while (0)
  f32x16 pA0, pA1, pB0, pB1; float mnA, mnB, alA, alB; bf16x8 pa0, pa1, pa2, pa3; const int NT = seq / KVBLK;
  constexpr int SE = 0, SO = 1;
  SLOAD(SE, 0); asm volatile("s_waitcnt vmcnt(0)" ::: "memory"); SWRITE(0, SE); __syncthreads();
  qkt(pA0, pA1, K_lds, qr, r32, hi); partialSM(pA0, pA1, m_reg, mnA, alA);
  SLOAD(SO, KVBLK); if (2 < NT) SLOAD(SE, 2 * KVBLK);
  SWAIT(); SWRITE(1, SO); __syncthreads();
  for (int j = 1; j + 1 < NT; j += 2) {
    SBAR(); qkt(pB0, pB1, (bf16_t*)((char*)K_lds + SHM_K), qr, r32, hi);
    finishSM(pA0, pA1, alA, l_reg, pa0, pa1, pa2, pa3); SBAR();
    SLOAD(SO, (j + 2) * KVBLK); SBAR();
    pv_d0(o, vb0, pa0, pa1, pa2, pa3); partialSM(pB0, pB1, m_reg, mnB, alB);
    __syncthreads(); SWAIT(); SWRITE(0, SE);
    RESC(alB); __syncthreads();
    SBAR(); qkt(pA0, pA1, K_lds, qr, r32, hi);
    finishSM(pB0, pB1, alB, l_reg, pa0, pa1, pa2, pa3); SBAR();
    if (j + 3 < NT) SLOAD(SE, (j + 3) * KVBLK); SBAR();
    pv_d0(o, vb0 + (int)SHM_V, pa0, pa1, pa2, pa3); partialSM(pA0, pA1, m_reg, mnA, alA);
    __syncthreads(); SWAIT(); SWRITE(1, SO);
    RESC(alA); __syncthreads();
  }
  SBAR(); qkt(pB0, pB1, (bf16_t*)((char*)K_lds + SHM_K), qr, r32, hi);
  finishSM(pA0, pA1, alA, l_reg, pa0, pa1, pa2, pa3); SBAR();
  pv_d0(o, vb0, pa0, pa1, pa2, pa3); partialSM(pB0, pB1, m_reg, mnB, alB);
  __syncthreads(); RESC(alB);
  finishSM(pB0, pB1, alB, l_reg, pa0, pa1, pa2, pa3); SBAR();
  pv_d0(o, vb0 + (int)SHM_V, pa0, pa1, pa2, pa3);
  if (hi == 0) li_l[r32] = l_reg; asm volatile("s_waitcnt lgkmcnt(0)" ::: "memory");
  float rli[16];
#pragma unroll
  for (int r = 0; r < 16; ++r) rli[r] = __builtin_amdgcn_rcpf(li_l[crow(r, hi)]);
  bf16_t* stg = (bf16_t*)(lds + OST_OFF) + wid * 4096;
#pragma unroll
  for (int r = 0; r < 16; ++r) { const int orow = crow(r, hi);
#pragma unroll
    for (int d0 = 0; d0 < 4; ++d0) stg[orow * 128 + d0 * 32 + r32] = (bf16_t)f2bf(o[d0][r] * rli[r]); }
  asm volatile("s_waitcnt lgkmcnt(0)" ::: "memory");
#pragma unroll
  for (int i = 0; i < 8; ++i) { const int row = i * 4 + (lane >> 4), ch = lane & 15;
    const u32x4 v = *(const u32x4*)(stg + row * 128 + ch * 8);
    const size_t off = (size_t)(wid * QBLK + row) * LDO + ch * 8;
    const u32x4 s = *(const u32x4*)(Gb + off);
    u32x4 w; w.x = pk2(bf_lo(v.x) * bf_lo(s.x), bf_hi(v.x) * bf_hi(s.x)); w.y = pk2(bf_lo(v.y) * bf_lo(s.y), bf_hi(v.y) * bf_hi(s.y));
    w.z = pk2(bf_lo(v.z) * bf_lo(s.z), bf_hi(v.z) * bf_hi(s.z)); w.w = pk2(bf_lo(v.w) * bf_lo(s.w), bf_hi(v.w) * bf_hi(s.w));
    *(u32x4*)(Mb + off) = w; }
  asm volatile("s_waitcnt lgkmcnt(0)" ::: "memory");
  __syncthreads();
#undef SLOAD
#undef SWRITE
#undef SWAIT
#undef RESC
}
#undef KSWZ
#undef SBAR
}

#define XB_TMO      128
#define XB_XCNT(j)  (256  + 64 * (j))
#define XB_XSUB(j)  (1280 + 64 * (j))
#define XB_XGEN(j)  (2304 + 64 * (j))
#define XB_TOP      3328
#define XB_TOPGEN   3392
#define XCD_BAR_WORDS 3456
#define XB_SPIN_CAP (1u << 18)
__device__ __forceinline__ unsigned xb_ld(unsigned* p)              { return __hip_atomic_load(p, __ATOMIC_RELAXED, __HIP_MEMORY_SCOPE_AGENT); }
__device__ __forceinline__ unsigned xb_add(unsigned* p, unsigned v) { return __hip_atomic_fetch_add(p, v, __ATOMIC_RELAXED, __HIP_MEMORY_SCOPE_AGENT); }
__device__ __forceinline__ unsigned xb_xcc_id() { return (unsigned)__builtin_amdgcn_s_getreg((3 << 11) | 20) & 0xFu; }
#define XB_SPIN(cond, bar) do { unsigned _sp = 0; while (cond) { __builtin_amdgcn_s_sleep(1); \
    if ((++_sp & 255u) == 0u) { if (xb_ld(&(bar)[XB_TMO])) break; if (_sp > XB_SPIN_CAP) { atomicAdd(&(bar)[XB_TMO], 1u); break; } } } } while (0)
struct XcdBarrier { unsigned* bar; unsigned x; volatile LAS unsigned* st; };
__device__ __forceinline__ XcdBarrier xcd_barrier_post(unsigned* bar, volatile LAS unsigned* st) {
    XcdBarrier b; b.bar = bar; b.x = xb_xcc_id(); b.st = st;
    if (threadIdx.x == 0) (void)xb_add(&bar[XB_XCNT(b.x)], 1u);
    return b;
}
__device__ __forceinline__ void xcd_barrier_complete(unsigned* bar, unsigned x, unsigned& nloc, unsigned& nx) {
    const unsigned G = gridDim.x * gridDim.y * gridDim.z;
    unsigned sum, cnt, mine, sp = 0u;
    for (;;) {
        sum = 0u; cnt = 0u; mine = 0u;
#pragma unroll
        for (unsigned j = 0; j < 16; ++j) { const unsigned c = xb_ld(&bar[XB_XCNT(j)]); sum += c; cnt += (c > 0u) ? 1u : 0u; mine = (j == x) ? c : mine; }
        if (sum == G) break;
        __builtin_amdgcn_s_sleep(1);
        if ((++sp & 255u) == 0u) { if (xb_ld(&bar[XB_TMO])) break; if (sp > XB_SPIN_CAP) { atomicAdd(&bar[XB_TMO], 1u); break; } }
    }
    nloc = mine > 0u ? mine : 1u; nx = cnt > 0u ? cnt : 1u;
}
__device__ __forceinline__ void xcd_barrier(const XcdBarrier& b) {
    asm volatile("s_waitcnt vmcnt(0)" ::: "memory");
    __syncthreads();
    if (threadIdx.x == 0) {
        unsigned* bar = b.bar;
        __builtin_amdgcn_s_waitcnt(0);
        unsigned nloc = b.st[0], nx = b.st[1];
        if (nloc == 0u) { xcd_barrier_complete(bar, b.x, nloc, nx); b.st[0] = nloc; b.st[1] = nx; }
        const unsigned old = xb_add(&bar[XB_XSUB(b.x)], 1u);
        const unsigned gen = old / nloc;
        if (old + 1u == (gen + 1u) * nloc) {
            __builtin_amdgcn_fence(__ATOMIC_RELEASE, "agent");
            asm volatile("s_waitcnt vmcnt(0)" ::: "memory");
            const unsigned og = xb_add(&bar[XB_TOP], 1u);
            const unsigned tg = og / nx;
            if (og + 1u == (tg + 1u) * nx) xb_add(&bar[XB_TOPGEN], 1u);
            else XB_SPIN(xb_ld(&bar[XB_TOPGEN]) == tg, bar);
            __builtin_amdgcn_fence(__ATOMIC_ACQUIRE, "agent");
            xb_add(&bar[XB_XGEN(b.x)], 1u);
            asm volatile("s_waitcnt vmcnt(0)" ::: "memory");
        } else {
            XB_SPIN(xb_ld(&bar[XB_XGEN(b.x)]) == gen, bar);
            __builtin_amdgcn_fence(__ATOMIC_ACQUIRE, "agent");
            asm volatile("s_waitcnt vmcnt(0)" ::: "memory");
        }
    }
    __syncthreads();
}

struct Args {
    const float *x, *c, *ctx, *c_ctx, *ada_w, *ada_b, *norm_g, *w_in, *q_norm_g, *k_norm_g, *pool_w, *pool_scale, *fourier_w, *w_out, *final_norm_g;
    float* out; unsigned char* ws; int ph_lo, ph_hi;
};

__device__ __forceinline__ void transpose_item(const float* W, int ldw, int col0, int ncols, bf16_t* WT, int dst_row0, LAS float* scr, int item, int lane) {
    const int nblk = ncols / 32, kb = item / nblk, nb = item % nblk, k0 = 64 * kb, n0 = 32 * nb;
#pragma unroll 8
    for (int i = 0; i < 32; ++i) { const int kk = 2 * i + (lane >> 5); scr[kk * 33 + (lane & 31)] = W[(size_t)(k0 + kk) * ldw + col0 + n0 + (lane & 31)]; }
    asm volatile("s_waitcnt lgkmcnt(0)" ::: "memory");
    const int cidx = lane & 7;
#pragma unroll
    for (int j = 0; j < 4; ++j) { const int n = (lane >> 3) + 8 * j; const LAS float* s = scr + (8 * cidx) * 33 + n;
        u32x4 o; o.x = pk2(s[0 * 33], s[1 * 33]); o.y = pk2(s[2 * 33], s[3 * 33]); o.z = pk2(s[4 * 33], s[5 * 33]); o.w = pk2(s[6 * 33], s[7 * 33]);
        *(u32x4*)(WT + (size_t)(dst_row0 + n0 + n) * 2048 + k0 + 8 * cidx) = o; }
    asm volatile("s_waitcnt lgkmcnt(0)" ::: "memory");
}

__device__ __forceinline__ void phase_p0a(const Args& a, LAS unsigned char* lds, int vcu, int G) {
    const int tid = opaque_tid(), lane = tid & 63, wave = __builtin_amdgcn_readfirstlane(tid >> 6);
    const int gw = vcu * NWAVES + wave, NGW = G * NWAVES;
    const int gt = vcu * NTHR + tid, NGT = G * NTHR;
    unsigned char* ws = opaque_ptr(a.ws);
    {
        float* modp = (float*)(ws + WS_MODP);
        for (int it = gw; it < 2 * 24 * 32; it += NGW) {
            const int kc = it & 31, cc = (it >> 5) % 24, l = it / (32 * 24);
            const int k = kc * 64 + lane;
            float sv[9];
#pragma unroll
            for (int r = 0; r < 8; ++r) sv[r] = silu_f(a.c[r * 2048 + k]);
            sv[8] = silu_f(a.c_ctx[k]);
            f32x4 acc[9];
#pragma unroll
            for (int r = 0; r < 9; ++r) acc[r] = (f32x4){0.f, 0.f, 0.f, 0.f};
            const float* wp = a.ada_w + ((size_t)l * 2048 + kc * 64) * 6144 + cc * 256 + lane * 4;
#pragma unroll 4
            for (int kk = 0; kk < 64; ++kk) {
                const f32x4 w = *(const f32x4*)(wp + (size_t)kk * 6144);
#pragma unroll
                for (int r = 0; r < 9; ++r) { const float s = __shfl(sv[r], kk); acc[r] += w * s; }
            }
#pragma unroll
            for (int r = 0; r < 9; ++r) *(f32x4*)(modp + (((size_t)kc * 2 + l) * 9 + r) * 6144 + cc * 256 + lane * 4) = acc[r];
        }
    }
    {
        LAS float* scr = (LAS float*)(lds + wave * 16384);
        constexpr int I_QKV = 32 * 48, I_G = 32 * 64, I_O = 32 * 64, I_L = I_QKV + I_G + I_O;
        for (int it = gw; it < 2 * I_L; it += NGW) {
            const int l = it / I_L; int r = it % I_L;
            const float* win = a.w_in + (size_t)l * 2048 * INW;
            bf16_t* wint = (bf16_t*)(ws + WS_WINT) + (size_t)l * 4096 * 2048;
            if (r < I_QKV) { transpose_item(win, INW, 0, 1536, wint, 0, scr, r, lane); continue; } r -= I_QKV;
            if (r < I_G) { transpose_item(win, INW, OFFG, 2048, wint, 2048, scr, r, lane); continue; } r -= I_G;
            transpose_item(a.w_out + (size_t)l * 2048 * 2048, 2048, 0, 2048, (bf16_t*)(ws + WS_WOUTT) + (size_t)l * 2048 * 2048, 0, scr, r, lane);
        }
    }
    {
        bf16_t* dl = (bf16_t*)(ws + WS_DFTL);
        for (int ch = gt; ch < 2048 * 128; ch += NGT) {
            const int r = ch >> 7, n0 = (ch & 127) * 8, part = r >> 10, k = r & 1023;
            float v[8];
#pragma unroll
            for (int e = 0; e < 8; ++e) { const int idx = (k * (n0 + e)) & 2047; const float t = (float)idx * (1.0f / 1024.0f); v[e] = part ? sinpif(t) : cospif(t); }
            u32x4 o; o.x = pk2(v[0], v[1]); o.y = pk2(v[2], v[3]); o.z = pk2(v[4], v[5]); o.w = pk2(v[6], v[7]);
            *(u32x4*)(dl + (size_t)r * 1024 + n0) = o;
        }
        bf16_t* dc = (bf16_t*)(ws + WS_DFTC);
        for (int ch = gt; ch < 256 * 64; ch += NGT) {
            const int k = ch >> 6, j0 = (ch & 63) * 8, part = j0 >> 8, n0 = j0 & 255;
            float v[8];
#pragma unroll
            for (int e = 0; e < 8; ++e) { const int idx = (k * (n0 + e)) & 255; const float t = (float)idx * (1.0f / 128.0f); v[e] = part ? -sinpif(t) : cospif(t); }
            u32x4 o; o.x = pk2(v[0], v[1]); o.y = pk2(v[2], v[3]); o.z = pk2(v[4], v[5]); o.w = pk2(v[6], v[7]);
            *(u32x4*)(dc + (size_t)k * 512 + j0) = o;
        }
    }
    {
        float* rc = (float*)(ws + WS_ROPE); float* rs = rc + 2048;
        for (int e = gt; e < 2048; e += NGT) { const int p = e >> 5, i = e & 31;
            const float inv = powf(10000.0f, -(float)(2 * i) / 64.0f); const float ang = (float)p * inv;
            rc[e] = cosf(ang); rs[e] = sinf(ang); }
    }
    {
        float* mf = (float*)(ws + WS_MFOLD);
        for (int e = gt; e < 2 * 4 * 2 * 128 * 128; e += NGT) {
            const int d = e & 127, cch = (e >> 7) & 127, part = (e >> 14) & 1, lg = e >> 15;
            const float* fw = a.fourier_w + (size_t)lg * 128 * 128 + d;
            float s = 0.f;
            for (int m = 0; m < 128; ++m) { const float t = (float)((m * cch) & 127) * (1.0f / 64.0f); const float tr = part ? sinpif(t) : cospif(t); s = fmaf(tr, fw[m * 128], s); }
            mf[e] = s;
        }
    }
}

__device__ __forceinline__ void phase_p0b(const Args& a, int vcu, int G) {
    const int tid = opaque_tid(), lane = tid & 63, wave = __builtin_amdgcn_readfirstlane(tid >> 6);
    const int gw = vcu * NWAVES + wave, NGW = G * NWAVES;
    const int gt = vcu * NTHR + tid, NGT = G * NTHR;
    unsigned char* ws = opaque_ptr(a.ws);
    {
        const float* modp = (const float*)(ws + WS_MODP); float* mod = (float*)(ws + WS_MOD);
        for (int e = gt; e < 2 * 9 * 6144; e += NGT) {
            const int l = e / (9 * 6144), col = e % 6144; const int rem = e - l * 9 * 6144;
            float s = a.ada_b[l * 6144 + col];
            for (int kc = 0; kc < 32; ++kc) s += modp[((size_t)kc * 2 + l) * 9 * 6144 + rem];
            mod[e] = s;
        }
    }
    {
        for (int it = gw; it < 24 * 8 * 32; it += NGW) {
            const int kc = it & 31, dch = (it >> 5) & 7, mat = it >> 8;
            const int l = mat / 12, mm = mat % 12;
            const float* Mat; bf16_t* dst; int col0;
            if (mm < 4) { const int g = mm; Mat = a.pool_w + (size_t)(l * 4 + g) * 128 * 128; col0 = OFFP + g * 128;
                dst = (bf16_t*)(ws + WS_WINT) + ((size_t)l * 4096 + 1536 + g * 128) * 2048; }
            else { const int part = (mm - 4) >> 2, g = (mm - 4) & 3; Mat = (const float*)(ws + WS_MFOLD) + (size_t)((l * 4 + g) * 2 + part) * 128 * 128; col0 = OFFF + g * 128;
                dst = (bf16_t*)(ws + WS_WFT) + ((size_t)l * 1024 + part * 512 + g * 128) * 2048; }
            const int k = kc * 64 + lane, d0 = dch * 16;
            const float* wrow = a.w_in + ((size_t)l * 2048 + k) * INW + col0;
            float acc[16];
#pragma unroll
            for (int d = 0; d < 16; ++d) acc[d] = 0.f;
            for (int c4 = 0; c4 < 32; ++c4) {
                const f32x4 w = *(const f32x4*)(wrow + c4 * 4);
#pragma unroll
                for (int i = 0; i < 4; ++i) { const float* mr = Mat + (size_t)(c4 * 4 + i) * 128 + d0;
#pragma unroll
                    for (int d = 0; d < 16; ++d) acc[d] = fmaf(w[i], mr[d], acc[d]); }
            }
#pragma unroll
            for (int d = 0; d < 16; ++d) dst[(size_t)(d0 + d) * 2048 + k] = (bf16_t)f2bf(acc[d]);
        }
    }
}

__device__ __forceinline__ void phase_p1(const Args& a, int l, int vcu, int G) {
    const int tid = opaque_tid(), lane = tid & 63, wave = __builtin_amdgcn_readfirstlane(tid >> 6);
    const int gw = vcu * NWAVES + wave, NGW = G * NWAVES;
    unsigned char* ws = opaque_ptr(a.ws);
    const float* mod = (const float*)(ws + WS_MOD) + (size_t)l * 9 * 6144;
    const float* xl = l == 0 ? a.x : a.out; const float* xc = l == 0 ? a.ctx : (const float*)(ws + WS_XC1);
    const float* ng = a.norm_g + l * 2048;
    bf16_t* H = (bf16_t*)(ws + WS_H);
    for (int row = gw; row < MT; row += NGW) {
        const bool lat = row < ML; const int modrow = lat ? (row >> 11) : 8;
        const float* src = lat ? xl + (size_t)row * 2048 : xc + (size_t)(row - ML) * 2048;
        const f32x4* xr = (const f32x4*)src + lane;
        f32x4 v[8]; float s = 0.f;
#pragma unroll
        for (int j = 0; j < 8; ++j) { v[j] = xr[64 * j]; s += (v[j].x * v[j].x + v[j].y * v[j].y) + (v[j].z * v[j].z + v[j].w * v[j].w); }
        const float rstd = 1.0f / sqrtf(wave_sum(s) * (1.0f / 2048.0f) + EPS);
        const f32x4* gp = (const f32x4*)ng + lane; const f32x4* shp = (const f32x4*)(mod + (size_t)modrow * 6144) + lane; const f32x4* scp = (const f32x4*)(mod + (size_t)modrow * 6144 + 2048) + lane;
        u32x2* op = (u32x2*)(H + (size_t)row * 2048) + lane;
#pragma unroll
        for (int j = 0; j < 8; ++j) { const f32x4 g = gp[64 * j], sh = shp[64 * j], sc = scp[64 * j];
            const f32x4 y = (v[j] * rstd) * g * (sc + 1.0f) + sh;
            u32x2 w; w.x = pk2(y.x, y.y); w.y = pk2(y.z, y.w); op[64 * j] = w; }
    }
}

__device__ __forceinline__ void phase_p2b(const Args& a, int l, int vcu, int G) {
    const int tid = opaque_tid(), lane = tid & 63, wave = __builtin_amdgcn_readfirstlane(tid >> 6);
    const int gw = vcu * NWAVES + wave, NGW = G * NWAVES;
    unsigned char* ws = opaque_ptr(a.ws);
    bf16_t* QB = (bf16_t*)(ws + WS_QB); const bf16_t* KRAW = (const bf16_t*)(ws + WS_KRAW); bf16_t* KB = (bf16_t*)(ws + WS_KB);
    const float* rc = (const float*)(ws + WS_ROPE); const float* rs = rc + 2048;
    const int axis = lane >> 5, i = lane & 31, d1 = axis * 64 + i, d2 = d1 + 32;
    const float qg1 = a.q_norm_g[l * 128 + d1], qg2 = a.q_norm_g[l * 128 + d2], kg1 = a.k_norm_g[l * 128 + d1], kg2 = a.k_norm_g[l * 128 + d2];
    for (int row = gw; row < MT; row += NGW) {
        const bool lat = row < ML;
        float cs = 1.f, sn = 0.f;
        if (lat) { const int n = row & 2047, p = axis ? (n & 63) : (n >> 6); cs = rc[p * 32 + i]; sn = rs[p * 32 + i]; }
        const int h0 = (!lat && l == DEPTH - 1) ? 8 : 0;
        const int krow = kvrow(row);
        for (int h = h0; h < 10; ++h) {
            const bool isq = h < 8;
            const bf16_t* src = isq ? QB + (size_t)row * 1024 + h * 128 : KRAW + (size_t)row * 256 + (h - 8) * 128;
            bf16_t* dst = isq ? QB + (size_t)row * 1024 + h * 128 : KB + (size_t)krow * 256 + (h - 8) * 128;
            const float x1 = bf2f(src[d1]), x2 = bf2f(src[d2]);
            const float ss = wave_sum(x1 * x1 + x2 * x2);
            const float rstd = 1.0f / sqrtf(ss * (1.0f / 128.0f) + EPS);
            const float y1 = x1 * rstd * (isq ? qg1 : kg1), y2 = x2 * rstd * (isq ? qg2 : kg2);
            dst[d1] = (bf16_t)f2bf(y1 * cs - y2 * sn); dst[d2] = (bf16_t)f2bf(y2 * cs + y1 * sn);
        }
    }
    {
        const bf16_t* ABT = (const bf16_t*)(ws + WS_ABT); bf16_t* AEBO = (bf16_t*)(ws + WS_AEBO); float* NYQ = (float*)(ws + WS_NYQ);
        const bf16_t* SG = (const bf16_t*)(ws + WS_SG); bf16_t* MIX = (bf16_t*)(ws + WS_H);
        for (int it = gw; it < NB * 512; it += NGW) {
            const int b = it >> 9, ch = it & 511;
            const bf16_t* Ap = ABT + (size_t)it * 4096; const bf16_t* Bp = Ap + 2048;
            float alt = 0.f;
#pragma unroll
            for (int h = 0; h < 2; ++h) {
                const int n0 = (h * 64 + lane) * 8;
                const u32x4 av = *(const u32x4*)(Ap + n0), am = *(const u32x4*)(Ap + 2040 - n0), bv = *(const u32x4*)(Bp + n0), bm = *(const u32x4*)(Bp + 2040 - n0);
                const float a0m = n0 ? bf2f(Ap[2048 - n0]) : 0.f, b0m = n0 ? bf2f(Bp[2048 - n0]) : 0.f;
                float a[8] = {bf_lo(av.x), bf_hi(av.x), bf_lo(av.y), bf_hi(av.y), bf_lo(av.z), bf_hi(av.z), bf_lo(av.w), bf_hi(av.w)};
                float bb[8] = {bf_lo(bv.x), bf_hi(bv.x), bf_lo(bv.y), bf_hi(bv.y), bf_lo(bv.z), bf_hi(bv.z), bf_lo(bv.w), bf_hi(bv.w)};
                float ar[8] = {a0m, bf_hi(am.w), bf_lo(am.w), bf_hi(am.z), bf_lo(am.z), bf_hi(am.y), bf_lo(am.y), bf_hi(am.x)};
                float br[8] = {b0m, bf_hi(bm.w), bf_lo(bm.w), bf_hi(bm.z), bf_lo(bm.z), bf_hi(bm.y), bf_lo(bm.y), bf_hi(bm.x)};
#pragma unroll
                for (int e = 0; e < 8; ++e) { const float sg_ = (e & 1) ? -1.f : 1.f; alt += sg_ * (a[e] + ar[e]); }
                float ae[8], bo[8];
#pragma unroll
                for (int e = 0; e < 8; ++e) { ae[e] = a[e] + ar[e]; bo[e] = bb[e] - br[e]; }
                if (n0 == 0) bo[0] = 0.f;
                u32x4 o; o.x = pk2(ae[0], ae[1]); o.y = pk2(ae[2], ae[3]); o.z = pk2(ae[4], ae[5]); o.w = pk2(ae[6], ae[7]);
                *(u32x4*)(AEBO + ((size_t)(b * 2 + 0) * 512 + ch) * 1024 + n0) = o;
                u32x4 p; p.x = pk2(bo[0], bo[1]); p.y = pk2(bo[2], bo[3]); p.z = pk2(bo[4], bo[5]); p.w = pk2(bo[6], bo[7]);
                *(u32x4*)(AEBO + ((size_t)(b * 2 + 1) * 512 + ch) * 1024 + n0) = p;
            }
            const float a1024 = bf2f(Ap[1024]);
            const float tot = wave_sum(alt) + a1024;
            if (lane == 0) { NYQ[it] = a1024;
                const size_t off = (size_t)(b * SEQ + 1024) * 2048 + 1536 + ch;
                MIX[off] = (bf16_t)f2bf(tot * (1.0f / 512.0f) * bf2f(SG[off])); }
        }
    }
}

__device__ __forceinline__ void phase_pool(const Args& a, int l, int vcu, int G) {
    const int tid = opaque_tid(); const int gt = vcu * NTHR + tid, NGT = G * NTHR;
    unsigned char* ws = opaque_ptr(a.ws);
    const bf16_t* UPW = (const bf16_t*)(ws + WS_UPW); const bf16_t* SG = (const bf16_t*)(ws + WS_SG); bf16_t* MIX = (bf16_t*)(ws + WS_H);
    const int nrows = (l == 0) ? MT : ML;
    for (int it = gt; it < nrows * 64; it += NGT) {
        const int row = it >> 6, chunk = it & 63, gi = chunk >> 4, hw = 1 << gi;
        int t, nseq, seq0;
        if (row < ML) { t = row & 2047; nseq = SEQ; seq0 = row - t; } else { const int rc = row - ML; t = rc & 255; nseq = CTXL; seq0 = row - t; }
        const int lo = max(t - hw, 0), hi = min(t + hw - 1, nseq - 1);
        float s[8];
#pragma unroll
        for (int e = 0; e < 8; ++e) s[e] = 0.f;
        for (int j = lo; j <= hi; ++j) { const u32x4 v = *(const u32x4*)(UPW + (size_t)(seq0 + j) * 512 + chunk * 8);
            s[0] += bf_lo(v.x); s[1] += bf_hi(v.x); s[2] += bf_lo(v.y); s[3] += bf_hi(v.y); s[4] += bf_lo(v.z); s[5] += bf_hi(v.z); s[6] += bf_lo(v.w); s[7] += bf_hi(v.w); }
        const float rcnt = 1.0f / (float)(hi - lo + 1);
        const u32x4 own = *(const u32x4*)(UPW + (size_t)row * 512 + chunk * 8);
        const u32x4 sg = *(const u32x4*)(SG + (size_t)row * 2048 + 1024 + chunk * 8);
        const f32x4 ps0 = *(const f32x4*)(a.pool_scale + l * 512 + chunk * 8), ps1 = *(const f32x4*)(a.pool_scale + l * 512 + chunk * 8 + 4);
        float y[8];
        y[0] = (s[0] * rcnt - bf_lo(own.x)) * ps0[0] * bf_lo(sg.x); y[1] = (s[1] * rcnt - bf_hi(own.x)) * ps0[1] * bf_hi(sg.x);
        y[2] = (s[2] * rcnt - bf_lo(own.y)) * ps0[2] * bf_lo(sg.y); y[3] = (s[3] * rcnt - bf_hi(own.y)) * ps0[3] * bf_hi(sg.y);
        y[4] = (s[4] * rcnt - bf_lo(own.z)) * ps1[0] * bf_lo(sg.z); y[5] = (s[5] * rcnt - bf_hi(own.z)) * ps1[1] * bf_hi(sg.z);
        y[6] = (s[6] * rcnt - bf_lo(own.w)) * ps1[2] * bf_lo(sg.w); y[7] = (s[7] * rcnt - bf_hi(own.w)) * ps1[3] * bf_hi(sg.w);
        u32x4 o; o.x = pk2(y[0], y[1]); o.y = pk2(y[2], y[3]); o.z = pk2(y[4], y[5]); o.w = pk2(y[6], y[7]);
        *(u32x4*)(MIX + (size_t)row * 2048 + 1024 + chunk * 8) = o;
    }
}

__device__ __forceinline__ void phase_final(const Args& a, int vcu, int G) {
    const int tid = opaque_tid(), lane = tid & 63, wave = __builtin_amdgcn_readfirstlane(tid >> 6);
    const int gw = vcu * NWAVES + wave, NGW = G * NWAVES;
    for (int row = gw; row < ML; row += NGW) {
        f32x4* xr = (f32x4*)(a.out + (size_t)row * 2048) + lane;
        f32x4 v[8]; float s = 0.f;
#pragma unroll
        for (int j = 0; j < 8; ++j) { v[j] = xr[64 * j]; s += (v[j].x * v[j].x + v[j].y * v[j].y) + (v[j].z * v[j].z + v[j].w * v[j].w); }
        const float rstd = 1.0f / sqrtf(wave_sum(s) * (1.0f / 2048.0f) + EPS);
        const f32x4* gp = (const f32x4*)a.final_norm_g + lane;
#pragma unroll
        for (int j = 0; j < 8; ++j) xr[64 * j] = (v[j] * rstd) * gp[64 * j];
    }
}

constexpr int N_PHASES = 13;
__global__ void __launch_bounds__(NTHR, 2) mega_fwd(Args a) {
    extern __shared__ __attribute__((aligned(16))) unsigned char lds_raw[];
    LAS unsigned char* lds = (LAS unsigned char*)lds_raw;
    const int G = gridDim.x, bx = blockIdx.x;
    const int vcu = (G % 8 == 0) ? (bx % 8) * (G / 8) + bx / 8 : bx;
    unsigned char* ws = opaque_ptr(a.ws);
    volatile LAS unsigned* misc = (volatile LAS unsigned*)(lds + MISC_OFF);
    if (threadIdx.x < 2) misc[threadIdx.x] = 0u;
    __syncthreads();
    XcdBarrier bar = xcd_barrier_post((unsigned*)(a.ws + WS_CTL), misc);
    bf16_t* H = (bf16_t*)(ws + WS_H); bf16_t* QB = (bf16_t*)(ws + WS_QB); bf16_t* KRAW = (bf16_t*)(ws + WS_KRAW);
    bf16_t* KB = (bf16_t*)(ws + WS_KB); bf16_t* VB = (bf16_t*)(ws + WS_VB); bf16_t* UPW = (bf16_t*)(ws + WS_UPW); bf16_t* SG = (bf16_t*)(ws + WS_SG);
    bf16_t* ABT = (bf16_t*)(ws + WS_ABT); bf16_t* ABTC = (bf16_t*)(ws + WS_ABTC);

    for (int ph = a.ph_lo; ph < a.ph_hi; ++ph) {
        if (ph == 0) phase_p0a(a, lds, vcu, G);
        else if (ph == 1) phase_p0b(a, vcu, G);
        else if (ph == N_PHASES - 1) phase_final(a, vcu, G);
        else {
            const int l = (ph - 2) / 5, s = (ph - 2) % 5;
            const bf16_t* WINT = (const bf16_t*)(ws + WS_WINT) + (size_t)l * 4096 * 2048;
            const bf16_t* WFT = (const bf16_t*)(ws + WS_WFT) + (size_t)l * 1024 * 2048;
            const bf16_t* WOUTT = (const bf16_t*)(ws + WS_WOUTT) + (size_t)l * 2048 * 2048;
            if (s == 0) phase_p1(a, l, vcu, G);
            else if (s == 1) {
                { pg8::Gemm g = pg8::make_gemm(H, WINT, 2048, 2048, 2048); pg8::StaticOrder S; S.init((l == 0 ? MT : ML) / 256, 16, 1, G, bx);
                  EpiInProj E{QB, KRAW, VB, UPW, SG, 0, 0}; pg8::gemm_phase<EpiInProj>(lds, g, S, E); }
                if (l != 0) { pg8::Gemm g = pg8::make_gemm(H + (size_t)ML * 2048, WINT + (size_t)1024 * 2048, 2048, 2048, 2048); pg8::StaticOrder S; S.init(MC / 256, 2, 1, G, (bx + 64) % G);
                  EpiInProj E{QB, KRAW, VB, UPW, SG, ML, 4}; pg8::gemm_phase<EpiInProj>(lds, g, S, E); }
                { pg8::Gemm g = pg8::make_gemm(WFT, H, 2048, 2048, 2048); pg8::StaticOrder S; S.init(4, (l == 0 ? MT : ML) / 256, 1, G, (bx + 128) % G);
                  EpiFourT E{ABT, ABTC}; pg8::gemm_phase<EpiFourT>(lds, g, S, E); }
            }
            else if (s == 2) phase_p2b(a, l, vcu, G);
            else if (s == 3) {
                const int nU = 512 + (l == 0 ? 64 : 0);
                for (int i = vcu; i < nU; i += G) {
                    int b, h, kvh, seq; size_t qrow0;
                    if (i < 512) { const int pair = i >> 5, w = i & 31; b = pair >> 1; kvh = pair & 1; h = kvh * 4 + (w >> 3); qrow0 = (size_t)b * SEQ + (w & 7) * 256; seq = SKV; }
                    else { const int j = i - 512; b = j >> 3; h = j & 7; kvh = h >> 2; qrow0 = (size_t)ML + b * CTXL; seq = CTXL; }
                    att::attn_dense_body(QB + qrow0 * 1024 + h * 128, KB + (size_t)b * SKV * 256 + kvh * 128, VB + (size_t)b * SKV * 256 + kvh * 128,
                                         SG + qrow0 * 2048 + h * 128, H + qrow0 * 2048 + h * 128, seq, (char*)lds_raw);
                }
                { pg8::Gemm g{(const bf16_t*)(ws + WS_DFTL), (const bf16_t*)(ws + WS_AEBO), 1024, 1024, 1024, 128L * 1024, 1024L * 1024, 128L * 1024, 512L * 1024, 0, 2L * 512 * 1024};
                  pg8::StaticOrder S; S.init(8, 4, 8, G, bx);
                  EpiDftF E{H, SG, (const float*)(ws + WS_NYQ), 1.0f / 512.0f}; pg8::gemm_phase<EpiDftF>(lds, g, S, E); }
                if (l == 0) { pg8::Gemm g = pg8::make_gemm((const bf16_t*)(ws + WS_DFTC), ABTC, 512, 512, 512, 0, (long)512 * 512); pg8::StaticOrder S; S.init(1, 2, 8, G, (bx + 64) % G);
                  EpiDft E{H, SG, ML, CTXL, 0.005524271728019903f}; pg8::gemm_phase<EpiDft>(lds, g, S, E); }
                phase_pool(a, l, vcu, G);
            }
            else {
                pg8::Gemm g = pg8::make_gemm(H, WOUTT, 2048, 2048, 2048); pg8::StaticOrder S; S.init((l == 0 ? MT : ML) / 256, 8, 1, G, bx);
                EpiOut E{l == 0 ? a.x : a.out, a.ctx, a.out, (float*)(ws + WS_XC1), (const float*)(ws + WS_MOD) + (size_t)l * 9 * 6144};
                pg8::gemm_phase<EpiOut>(lds, g, S, E);
            }
        }
        if (ph + 1 < a.ph_hi) xcd_barrier(bar);
    }
}

extern "C" void kernel_launch(void* const* d_in, const int* in_sizes, int n_in, void* d_out, int out_size, void* d_ws, size_t ws_size, hipStream_t stream) {
    static int grid = 0;
    if (grid == 0) {
        if (n_in != 15 || out_size != ML * DM || ws_size < WS_END) { fprintf(stderr, "kernel_launch: unexpected shapes (n_in %d out %d ws %zu)\n", n_in, out_size, ws_size); grid = -1; return; }
        int dev = 0, cus = 0, per_cu = 0;
        hipGetDevice(&dev); hipDeviceGetAttribute(&cus, hipDeviceAttributeMultiprocessorCount, dev);
        if (hipFuncSetAttribute((const void*)mega_fwd, hipFuncAttributeMaxDynamicSharedMemorySize, LDS_BYTES) != hipSuccess) { fprintf(stderr, "kernel_launch: hipFuncSetAttribute failed\n"); grid = -1; return; }
        if (hipOccupancyMaxActiveBlocksPerMultiprocessor(&per_cu, (const void*)mega_fwd, NTHR, LDS_BYTES) != hipSuccess || per_cu < 1) { fprintf(stderr, "kernel_launch: occupancy query failed (%d)\n", per_cu); per_cu = 1; }
        (void)hipGetLastError();
        grid = cus * (per_cu > 1 ? 1 : per_cu);
        fprintf(stderr, "kernel_launch: grid %d (cus %d, per_cu %d)\n", grid, cus, per_cu);
    }
    if (grid < 0) return;
    Args a{};
    a.x = (const float*)d_in[0]; a.c = (const float*)d_in[1]; a.ctx = (const float*)d_in[2]; a.c_ctx = (const float*)d_in[3];
    a.ada_w = (const float*)d_in[4]; a.ada_b = (const float*)d_in[5]; a.norm_g = (const float*)d_in[6]; a.w_in = (const float*)d_in[7];
    a.q_norm_g = (const float*)d_in[8]; a.k_norm_g = (const float*)d_in[9]; a.pool_w = (const float*)d_in[10]; a.pool_scale = (const float*)d_in[11];
    a.fourier_w = (const float*)d_in[12]; a.w_out = (const float*)d_in[13]; a.final_norm_g = (const float*)d_in[14];
    a.out = (float*)d_out; a.ws = (unsigned char*)d_ws;
    if (hipMemsetAsync((char*)d_ws + WS_CTL, 0, 16384, stream) != hipSuccess) { fprintf(stderr, "kernel_launch: memset failed\n"); return; }
#if MK_MULTI
    for (int ph = 0; ph < N_PHASES; ++ph) { a.ph_lo = ph; a.ph_hi = ph + 1; hipLaunchKernelGGL(mega_fwd, dim3(grid), dim3(NTHR), LDS_BYTES, stream, a); }
#else
    a.ph_lo = 0; a.ph_hi = N_PHASES;
    void* args[] = {&a};
    hipError_t e = hipLaunchCooperativeKernel((const void*)mega_fwd, dim3(grid), dim3(NTHR), args, LDS_BYTES, stream);
    if (e != hipSuccess) fprintf(stderr, "kernel_launch: cooperative launch failed: %s (grid %d)\n", hipGetErrorString(e), grid);
#endif
}
```

```cpp
#include <hip/hip_runtime.h>
#include <hip/hip_cooperative_groups.h>
#include <hip/hip_bf16.h>
#include <cstdio>
#include <cstdint>
namespace cg = cooperative_groups;

#ifndef PROBE_MASK
#define PROBE_MASK 0
#endif
#ifndef PROBE_EPU
#define PROBE_EPU 200
#endif
#ifndef MK_MULTI
#define MK_MULTI 0
#endif

constexpr int DM = 2048, NB = 8, SEQ = 2048, CTXL = 256, DEPTH = 2;
constexpr int ML = NB * SEQ, MC = NB * CTXL, MT = ML + MC, SKV = SEQ + CTXL;
constexpr int INW = 4608, OFFP = 1536, OFFF = 2048, OFFG = 2560;
constexpr float EPS = 1e-6f;
constexpr int NWAVES = 8, NTHR = 512;

constexpr size_t MiB = 1u << 20;
constexpr size_t WS_CTL = 0;
constexpr size_t WS_MODP = 1 * MiB;
constexpr size_t WS_MOD = 16 * MiB;
constexpr size_t WS_ROPE = 16 * MiB + 512 * 1024;
constexpr size_t WS_MFOLD = 17 * MiB;
constexpr size_t WS_WINT = 18 * MiB;
constexpr size_t WS_WFT = 50 * MiB;
constexpr size_t WS_WOUTT = 58 * MiB;
constexpr size_t WS_DFTL = 74 * MiB;
constexpr size_t WS_DFTC = 90 * MiB;
constexpr size_t WS_H = 91 * MiB;
constexpr size_t WS_QB = 163 * MiB;
constexpr size_t WS_KRAW = 199 * MiB;
constexpr size_t WS_KB = 208 * MiB;
constexpr size_t WS_VB = 217 * MiB;
constexpr size_t WS_UPW = 226 * MiB;
constexpr size_t WS_SG = 244 * MiB;
constexpr size_t WS_ABT = 316 * MiB;
constexpr size_t WS_ABTC = 348 * MiB;
constexpr size_t WS_XC1 = 352 * MiB;
constexpr size_t WS_AEBO = 368 * MiB;
constexpr size_t WS_NYQ = 384 * MiB;
constexpr size_t WS_D0 = 385 * MiB;
constexpr size_t WS_D1 = WS_SG;
constexpr size_t WS_END = 457 * MiB;

constexpr int RING_BYTES = 131072;
constexpr int OST_OFF = 66 * 1024;
constexpr int MISC_OFF = 132 * 1024;
constexpr int LDS_BYTES = 136 * 1024;

#define LAS __attribute__((address_space(3)))
typedef unsigned short bf16_t;
typedef short bf16x8 __attribute__((ext_vector_type(8)));
typedef float f32x4 __attribute__((ext_vector_type(4)));
typedef float f32x16 __attribute__((ext_vector_type(16)));
typedef short s16x4 __attribute__((ext_vector_type(4)));
typedef unsigned u32x4 __attribute__((ext_vector_type(4)));
typedef unsigned u32x2 __attribute__((ext_vector_type(2)));

__device__ __forceinline__ int opaque_tid() { int t = threadIdx.x; asm volatile("" : "+v"(t)); return t; }
template <class T> __device__ __forceinline__ T* opaque_ptr(T* p) { int z = 0; asm volatile("" : "+s"(z)); return p + z; }
__device__ __forceinline__ unsigned f2bf(float f) { unsigned u = __builtin_bit_cast(unsigned, f); return (u + 0x7fffu + ((u >> 16) & 1u)) >> 16; }
typedef float f32x2_t __attribute__((ext_vector_type(2))); typedef __bf16 bf16x2_t __attribute__((ext_vector_type(2)));
__device__ __forceinline__ unsigned pk2(float lo, float hi) { f32x2_t v = {lo, hi}; bf16x2_t b = __builtin_convertvector(v, bf16x2_t); return __builtin_bit_cast(unsigned, b); }
__device__ __forceinline__ float bf_lo(unsigned w) { return __builtin_bit_cast(float, w << 16); }
__device__ __forceinline__ float bf_hi(unsigned w) { return __builtin_bit_cast(float, w & 0xffff0000u); }
__device__ __forceinline__ float bf2f(bf16_t h) { return __builtin_bit_cast(float, (unsigned)h << 16); }
__device__ __forceinline__ unsigned cvt_pk_bf16(float lo, float hi) { return pk2(lo, hi); }
__device__ __forceinline__ float silu_f(float x) { return x / (1.0f + __expf(-x)); }
__device__ __forceinline__ float wave_sum(float v) {
#pragma unroll
    for (int o = 1; o < 64; o <<= 1) v += __shfl_xor(v, o);
    return v;
}
__device__ __forceinline__ int kvrow(int grow) {
    if (grow < ML) return (grow >> 11) * SKV + CTXL + (grow & 2047);
    const int rc = grow - ML; return (rc >> 8) * SKV + (rc & 255);
}

namespace pg8 {
constexpr int BM = 256, BK = 64, HALF = 128, HTB = HALF * BK * 2, NXCD = 8, WGM = 8;
__host__ __device__ __forceinline__ int lds_byte(int r, int c) { const int st = (r >> 4) * 2 + (c >> 5), rr = r & 15, cc = c & 31, ob = rr * 64 + cc * 2; return st * 1024 + (ob ^ (((ob >> 9) & 1) << 5)); }
__host__ __device__ __forceinline__ void stage_rc(int b, int& R, int& C) { const int st = b / 1024, sb = b % 1024, swz = sb ^ (((sb >> 9) & 1) << 5); R = (st >> 1) * 16 + swz / 64; C = (st & 1) * 32 + (swz % 64) / 2; }
__host__ __device__ __forceinline__ int perm32(int rho) { const int n = rho >> 4, i = rho & 15; return 8 * (i >> 2) + 4 * n + (i & 3); }

struct Unit { int pm, pn, z; };
struct Gemm { const bf16_t* A; const bf16_t* Bt; int lda, ldb, K; long tA, hA, tB, hB, zA, zB; };
__device__ __forceinline__ Gemm make_gemm(const bf16_t* A, const bf16_t* Bt, int lda, int ldb, int K, long zA = 0, long zB = 0) { return Gemm{A, Bt, lda, ldb, K, 256L * lda, 128L * lda, 256L * ldb, 128L * ldb, zA, zB}; }

struct StaticOrder {
    int nM, nN, nMN, nwg, G, c;
    __device__ void init(int nM_, int nN_, int nZ_, int G_, int c_) { nM = nM_; nN = nN_; nMN = nM_ * nN_; nwg = nMN * nZ_; G = G_; c = c_; }
    __device__ bool next(int i, Unit& u) const {
        const long L = (long)i * G + c; if (L >= nwg) return false;
        int wgid = (int)L; { const int q = nwg / NXCD, r = nwg % NXCD, xcd = wgid % NXCD, off = wgid / NXCD; wgid = (xcd < r ? xcd * (q + 1) : r * (q + 1) + (xcd - r) * q) + off; }
        u.z = wgid / nMN; wgid -= u.z * nMN;
        const int nig = WGM * nN, gid = wgid / nig, fm = gid * WGM, gsz = (nM - fm) < WGM ? (nM - fm) : WGM;
        u.pm = fm + ((wgid % nig) % gsz); u.pn = (wgid % nig) / gsz; return true;
    }
};

template <class Epi>
__device__ __forceinline__ void gemm_phase(LAS unsigned char* lds, const Gemm g, const StaticOrder& S, const Epi& E) {
    const int tid = opaque_tid(), wid = __builtin_amdgcn_readfirstlane(tid >> 6), lane = tid & 63, wr = wid >> 2, wc = wid & 3, fr = lane & 15, fq = lane >> 4;
    const int K = g.K, nt = K / BK;
    unsigned voffA[2], voffB[2];
#pragma unroll
    for (int i = 0; i < 2; ++i) { int R, C; stage_rc(tid * 16 + i * 8192, R, C); const int Rb = Epi::PERM ? ((R & ~31) + perm32(R & 31)) : R;
        voffA[i] = (unsigned)(R * g.lda + C) * 2u; voffB[i] = (unsigned)(Rb * g.ldb + C) * 2u; }
    const size_t kstep = (size_t)(BK * 2);
    const size_t hstepA = (size_t)g.hA * 2, hstepB = (size_t)g.hB * 2;
    const unsigned ldsw = (unsigned)wid * 1024u;
    const int aoff = lds_byte(wr * 64 + fr, fq * 8), boff = lds_byte(wc * 32 + fr, fq * 8);
#define PG8_SA(b, h) (((b) * 2 + (h)) * HTB)
#define PG8_SB(b, h) ((4 + (b) * 2 + (h)) * HTB)
#define PG8_STAGE(bufoff, gbase, voff) do { _Pragma("unroll") for (int _i = 0; _i < 2; ++_i) \
        __builtin_amdgcn_global_load_lds((const unsigned*)((const char*)(gbase) + (voff)[_i]), (LAS unsigned*)(lds + (bufoff) + ldsw + _i * 8192), 16, 0, 0); } while (0)
#define PG8_LDA(dst, b, h) do { _Pragma("unroll") for (int m = 0; m < 4; ++m) _Pragma("unroll") for (int k = 0; k < 2; ++k) dst[m][k] = *(const LAS bf16x8*)(lds + PG8_SA(b, h) + aoff + m * 2048 + k * 1024); } while (0)
#define PG8_LDB(dst, b, h) do { _Pragma("unroll") for (int n = 0; n < 2; ++n) _Pragma("unroll") for (int k = 0; k < 2; ++k) dst[n][k] = *(const LAS bf16x8*)(lds + PG8_SB(b, h) + boff + n * 2048 + k * 1024); } while (0)
#define PG8_MMA(ai, bj, At, Bt) do { __builtin_amdgcn_s_setprio(1); _Pragma("unroll") for (int m = 0; m < 4; ++m) _Pragma("unroll") for (int n = 0; n < 2; ++n) _Pragma("unroll") for (int k = 0; k < 2; ++k) \
        acc[ai][bj][m][n] = __builtin_amdgcn_mfma_f32_16x16x32_bf16(Bt[n][k], At[m][k], acc[ai][bj][m][n], 0, 0, 0); __builtin_amdgcn_s_setprio(0); } while (0)
#define PG8_WAIT_V(n) asm volatile("s_waitcnt vmcnt(" #n ")" ::: "memory")
#define PG8_WAIT_L(n) asm volatile("s_waitcnt lgkmcnt(" #n ")" ::: "memory")
#define PG8_BAR __builtin_amdgcn_s_barrier()
#define PG8_SCHED __builtin_amdgcn_sched_barrier(0)
    Unit cur, nxt; int ui = 0;
    if (!S.next(0, cur)) return;
    f32x4 acc[2][2][4][2];
#pragma unroll
    for (int a = 0; a < 2; ++a)
#pragma unroll
        for (int b = 0; b < 2; ++b)
#pragma unroll
            for (int m = 0; m < 4; ++m)
#pragma unroll
                for (int n = 0; n < 2; ++n) acc[a][b][m][n] = (f32x4){0.f, 0.f, 0.f, 0.f};
    bf16x8 At[4][2], B0[2][2], B1[2][2];
    const char* cA = (const char*)g.A + ((size_t)cur.z * g.zA + (size_t)cur.pm * g.tA) * 2;
    const char* cB = (const char*)g.Bt + ((size_t)cur.z * g.zB + (size_t)cur.pn * g.tB) * 2;
    PG8_STAGE(PG8_SB(0, 0), cB, voffB); PG8_STAGE(PG8_SB(0, 1), cB + hstepB, voffB); PG8_STAGE(PG8_SA(0, 0), cA, voffA); PG8_STAGE(PG8_SA(0, 1), cA + hstepA, voffA);
    if (wr == 1) PG8_BAR;
    PG8_WAIT_V(2); PG8_BAR;
    PG8_STAGE(PG8_SB(1, 0), cB + kstep, voffB); PG8_STAGE(PG8_SA(1, 0), cA + kstep, voffA); PG8_STAGE(PG8_SB(1, 1), cB + hstepB + kstep, voffB);
    PG8_WAIT_V(6); PG8_BAR;
    for (;;) {
        const bool has_next = S.next(ui + 1, nxt);
        const char* nA = has_next ? (const char*)g.A + ((size_t)nxt.z * g.zA + (size_t)nxt.pm * g.tA) * 2 : cA;
        const char* nB = has_next ? (const char*)g.Bt + ((size_t)nxt.z * g.zB + (size_t)nxt.pn * g.tB) * 2 : cB;
        for (int t = 0; t < nt; t += 2) {
            const bool last = (t == nt - 2);
            const char* a1 = cA + (size_t)(t + 1) * kstep;
            const char* a2 = last ? nA : cA + (size_t)(t + 2) * kstep; const char* b2 = last ? nB : cB + (size_t)(t + 2) * kstep;
            const char* a3 = a2 + kstep; const char* b3 = b2 + kstep;
            PG8_LDB(B0, 0, 0); PG8_LDB(B1, 0, 1); PG8_SCHED; PG8_LDA(At, 0, 0); PG8_STAGE(PG8_SA(1, 1), a1 + hstepA, voffA);
            PG8_WAIT_V(8); PG8_WAIT_L(0); PG8_BAR; PG8_MMA(0, 0, At, B0); PG8_MMA(0, 1, At, B1); PG8_BAR; PG8_SCHED;
            PG8_LDA(At, 0, 1); PG8_STAGE(PG8_SB(0, 0), b2, voffB); PG8_STAGE(PG8_SB(0, 1), b2 + hstepB, voffB); PG8_STAGE(PG8_SA(0, 0), a2, voffA);
            PG8_WAIT_V(8); PG8_WAIT_L(0); PG8_BAR; PG8_MMA(1, 0, At, B0); PG8_MMA(1, 1, At, B1); PG8_BAR; PG8_SCHED;
            PG8_LDB(B0, 1, 0); PG8_LDB(B1, 1, 1); PG8_SCHED; PG8_LDA(At, 1, 0); PG8_STAGE(PG8_SA(0, 1), a2 + hstepA, voffA);
            PG8_WAIT_V(8); PG8_WAIT_L(0); PG8_BAR; PG8_MMA(0, 0, At, B0); PG8_MMA(0, 1, At, B1); PG8_BAR; PG8_SCHED;
            PG8_LDA(At, 1, 1); PG8_STAGE(PG8_SB(1, 0), b3, voffB); PG8_STAGE(PG8_SB(1, 1), b3 + hstepB, voffB); PG8_STAGE(PG8_SA(1, 0), a3, voffA);
            PG8_WAIT_V(8); PG8_WAIT_L(0); PG8_BAR; PG8_MMA(1, 0, At, B0); PG8_MMA(1, 1, At, B1); PG8_BAR; PG8_SCHED;
        }
        if (wr == 0) PG8_BAR;
        E(acc, cur, wr, wc, fr, fq);
        if (!has_next) break;
#pragma unroll
        for (int a = 0; a < 2; ++a)
#pragma unroll
            for (int b = 0; b < 2; ++b)
#pragma unroll
                for (int m = 0; m < 4; ++m)
#pragma unroll
                    for (int n = 0; n < 2; ++n) acc[a][b][m][n] = (f32x4){0.f, 0.f, 0.f, 0.f};
        cur = nxt; cA = nA; cB = nB; ++ui;
        if (wr == 1) PG8_BAR;
    }
    PG8_WAIT_V(0);
    PG8_BAR;
#undef PG8_SA
#undef PG8_SB
#undef PG8_STAGE
#undef PG8_LDA
#undef PG8_LDB
#undef PG8_MMA
#undef PG8_WAIT_V
#undef PG8_WAIT_L
#undef PG8_BAR
#undef PG8_SCHED
}
}

typedef const f32x4 (&AccRef)[2][2][4][2];
struct EpiInProj {
    static constexpr bool PERM = true;
    bf16_t *QB, *KRAW, *VB, *UPW, *SG; int row_off, pn_base;
    __device__ __forceinline__ void operator()(AccRef acc, const pg8::Unit& u, int wr, int wc, int fr, int fq) const {
        const int pn = u.pn + pn_base;
        bf16_t* base; int ld, ccol; bool act = false, kvmap = false;
        if (pn < 4) { base = QB; ld = 1024; ccol = pn * 256; }
        else if (pn == 4) { base = KRAW; ld = 256; ccol = 0; }
        else if (pn == 5) { base = VB; ld = 256; ccol = 0; kvmap = true; }
        else if (pn < 8) { base = UPW; ld = 512; ccol = (pn - 6) * 256; }
        else { base = SG; ld = 2048; ccol = (pn - 8) * 256; act = true; }
        const int row0 = row_off + u.pm * 256 + wr * 64 + fr, col0 = ccol + wc * 32 + 8 * fq;
#pragma unroll
        for (int ai = 0; ai < 2; ++ai)
#pragma unroll
            for (int m = 0; m < 4; ++m) {
                const int grow = row0 + ai * 128 + m * 16; const int drow = kvmap ? kvrow(grow) : grow;
                bf16_t* rowp = base + (size_t)drow * ld + col0;
#pragma unroll
                for (int bj = 0; bj < 2; ++bj) { f32x4 v0 = acc[ai][bj][m][0], v1 = acc[ai][bj][m][1];
                    if (act) {
#pragma unroll
                        for (int e = 0; e < 4; ++e) { v0[e] = silu_f(v0[e]); v1[e] = silu_f(v1[e]); } }
                    u32x4 w; w.x = cvt_pk_bf16(v0[0], v0[1]); w.y = cvt_pk_bf16(v0[2], v0[3]); w.z = cvt_pk_bf16(v1[0], v1[1]); w.w = cvt_pk_bf16(v1[2], v1[3]);
                    *(u32x4*)(rowp + bj * 128) = w; } }
    }
};
struct EpiFourT {
    static constexpr bool PERM = true;
    bf16_t *ABT, *ABTC;
    __device__ __forceinline__ void operator()(AccRef acc, const pg8::Unit& u, int wr, int wc, int fr, int fq) const {
        const int tok0 = u.pn * 256;
        bf16_t* base; int nlen, n0, b;
        if (tok0 < ML) { b = tok0 >> 11; n0 = tok0 & 2047; nlen = SEQ; base = ABT; }
        else { const int tc = tok0 - ML; b = tc >> 8; n0 = 0; nlen = CTXL; base = ABTC; }
        const int row0 = u.pm * 256 + wr * 64 + fr, col0 = n0 + wc * 32 + 8 * fq;
#pragma unroll
        for (int ai = 0; ai < 2; ++ai)
#pragma unroll
            for (int m = 0; m < 4; ++m) {
                const int row = row0 + ai * 128 + m * 16, part = row >> 9, ch = row & 511;
                bf16_t* rowp = base + (((size_t)b * 512 + ch) * 2 + part) * nlen + col0;
#pragma unroll
                for (int bj = 0; bj < 2; ++bj) { const f32x4 v0 = acc[ai][bj][m][0], v1 = acc[ai][bj][m][1];
                    u32x4 w; w.x = cvt_pk_bf16(v0[0], v0[1]); w.y = cvt_pk_bf16(v0[2], v0[3]); w.z = cvt_pk_bf16(v1[0], v1[1]); w.w = cvt_pk_bf16(v1[2], v1[3]);
                    *(u32x4*)(rowp + bj * 128) = w; } }
    }
};
struct EpiDft {
    static constexpr bool PERM = true;
    bf16_t* MIX; const bf16_t* SG; int row_base, rows_per_z; float norm;
    __device__ __forceinline__ void operator()(AccRef acc, const pg8::Unit& u, int wr, int wc, int fr, int fq) const {
        const int row0 = row_base + u.z * rows_per_z + u.pm * 256 + wr * 64 + fr, col0 = 1536 + u.pn * 256 + wc * 32 + 8 * fq;
#pragma unroll
        for (int ai = 0; ai < 2; ++ai) {
            u32x4 sg[4][2];
#pragma unroll
            for (int m = 0; m < 4; ++m)
#pragma unroll
                for (int bj = 0; bj < 2; ++bj) sg[m][bj] = *(const u32x4*)(SG + (size_t)(row0 + ai * 128 + m * 16) * 2048 + col0 + bj * 128);
#pragma unroll
            for (int m = 0; m < 4; ++m) {
                const size_t off = (size_t)(row0 + ai * 128 + m * 16) * 2048 + col0;
#pragma unroll
                for (int bj = 0; bj < 2; ++bj) { const f32x4 v0 = acc[ai][bj][m][0] * norm, v1 = acc[ai][bj][m][1] * norm;
                    const u32x4 s = sg[m][bj];
                    u32x4 w; w.x = cvt_pk_bf16(v0[0] * bf_lo(s.x), v0[1] * bf_hi(s.x)); w.y = cvt_pk_bf16(v0[2] * bf_lo(s.y), v0[3] * bf_hi(s.y));
                    w.z = cvt_pk_bf16(v1[0] * bf_lo(s.z), v1[1] * bf_hi(s.z)); w.w = cvt_pk_bf16(v1[2] * bf_lo(s.w), v1[3] * bf_hi(s.w));
                    *(u32x4*)(MIX + off + bj * 128) = w; } }
            asm volatile("" ::: "memory");
        }
    }
};
struct EpiDftF {
    static constexpr bool PERM = true;
    bf16_t* MIX; const bf16_t* SG; const float* NYQ; float norm;
    __device__ __forceinline__ void gate_store(size_t off, const u32x4 s, f32x4 v0, f32x4 v1) const {
        u32x4 w; w.x = cvt_pk_bf16(v0[0] * bf_lo(s.x), v0[1] * bf_hi(s.x)); w.y = cvt_pk_bf16(v0[2] * bf_lo(s.y), v0[3] * bf_hi(s.y));
        w.z = cvt_pk_bf16(v1[0] * bf_lo(s.z), v1[1] * bf_hi(s.z)); w.w = cvt_pk_bf16(v1[2] * bf_lo(s.w), v1[3] * bf_hi(s.w));
        *(u32x4*)(MIX + off) = w;
    }
    __device__ __forceinline__ void operator()(AccRef acc, const pg8::Unit& u, int wr, int wc, int fr, int fq) const {
        const int b = u.z, ch0 = u.pn * 128 + wc * 32 + 8 * fq, kb = u.pm * 128 + wr * 64 + fr;
        const f32x4 t0 = *(const f32x4*)(NYQ + b * 512 + ch0), t1 = *(const f32x4*)(NYQ + b * 512 + ch0 + 4);
        u32x4 sl[4], sh[4];
#pragma unroll
        for (int m = 0; m < 4; ++m) { const int k = kb + m * 16;
            sl[m] = *(const u32x4*)(SG + (size_t)(b * SEQ + k) * 2048 + 1536 + ch0);
            sh[m] = *(const u32x4*)(SG + (size_t)(b * SEQ + (k ? SEQ - k : 0)) * 2048 + 1536 + ch0); }
#pragma unroll
        for (int m = 0; m < 4; ++m) {
            const int k = kb + m * 16; const float sgn = (k & 1) ? -1.0f : 1.0f;
            const f32x4 P0 = acc[0][0][m][0] + t0 * sgn, P1 = acc[0][0][m][1] + t1 * sgn, Q0 = acc[1][1][m][0], Q1 = acc[1][1][m][1];
            gate_store((size_t)(b * SEQ + k) * 2048 + 1536 + ch0, sl[m], (P0 - Q0) * norm, (P1 - Q1) * norm);
            if (k > 0) gate_store((size_t)(b * SEQ + SEQ - k) * 2048 + 1536 + ch0, sh[m], (P0 + Q0) * norm, (P1 + Q1) * norm);
        }
    }
};
struct EpiDelta {
    static constexpr bool PERM = true;
    bf16_t* D; const float* mod;
    __device__ __forceinline__ void operator()(AccRef acc, const pg8::Unit& u, int wr, int wc, int fr, int fq) const {
        const int rowt = u.pm * 256; const int modrow = rowt < ML ? (rowt >> 11) : 8;
        const int col0 = u.pn * 256 + wc * 32 + 8 * fq;
        f32x4 gv[2][2];
#pragma unroll
        for (int bj = 0; bj < 2; ++bj)
#pragma unroll
            for (int n = 0; n < 2; ++n) gv[bj][n] = *(const f32x4*)(mod + (size_t)modrow * 6144 + 4096 + col0 + bj * 128 + n * 4);
#pragma unroll
        for (int ai = 0; ai < 2; ++ai)
#pragma unroll
            for (int m = 0; m < 4; ++m) {
                bf16_t* rowp = D + (size_t)(rowt + ai * 128 + wr * 64 + m * 16 + fr) * 2048 + col0;
#pragma unroll
                for (int bj = 0; bj < 2; ++bj) { const f32x4 v0 = acc[ai][bj][m][0] * gv[bj][0], v1 = acc[ai][bj][m][1] * gv[bj][1];
                    u32x4 w; w.x = cvt_pk_bf16(v0[0], v0[1]); w.y = cvt_pk_bf16(v0[2], v0[3]); w.z = cvt_pk_bf16(v1[0], v1[1]); w.w = cvt_pk_bf16(v1[2], v1[3]);
                    *(u32x4*)(rowp + bj * 128) = w; } }
    }
};

namespace att {
constexpr int D = 128, QBLK = 32, KVBLK = 64, LDQ = 1024, LDK = 256, LDO = 2048;
constexpr float SCALE = 0.088388347648318440f, THR = 8.f;
constexpr size_t SHM_V = KVBLK * D * 2, SHM_K = KVBLK * D * 2;
#define KSWZ(row, colB) ((row) * 256 + ((colB) ^ (((row) & 7) << 4)))
#define SBAR() __builtin_amdgcn_sched_barrier(0)
__device__ __forceinline__ int crow(int r, int hi) { return (r & 3) + 8 * (r >> 2) + 4 * hi; }
__device__ __forceinline__ unsigned cvtpk(float lo, float hi) { unsigned r; asm volatile("v_cvt_pk_bf16_f32 %0, %1, %2" : "=v"(r) : "v"(lo), "v"(hi)); return r; }
__device__ __forceinline__ void partialSM(f32x16& p0, f32x16& p1, float& m_reg, float& mn, float& alpha) {
  constexpr float C = SCALE * 1.4426950408889634f;
  float pmax = p0[0]; for (int r = 1; r < 16; ++r) pmax = fmaxf(pmax, p0[r]); for (int r = 0; r < 16; ++r) pmax = fmaxf(pmax, p1[r]);
  { auto rr = __builtin_amdgcn_permlane32_swap(__float_as_uint(pmax), __float_as_uint(pmax), false, false);
    pmax = fmaxf(__uint_as_float(rr[0]), __uint_as_float(rr[1])); }
  if (__builtin_expect(__all(pmax - m_reg <= THR / SCALE), 1)) { mn = m_reg; alpha = 1.f; }
  else { mn = fmaxf(m_reg, pmax); alpha = __builtin_amdgcn_exp2f((m_reg - mn) * C); m_reg = mn; }
  float mnC = -mn * C;
  for (int r = 0; r < 16; ++r) p0[r] = fmaf(p0[r], C, mnC); for (int r = 0; r < 16; ++r) p1[r] = fmaf(p1[r], C, mnC);
  for (int r = 0; r < 16; ++r) p0[r] = __builtin_amdgcn_exp2f(p0[r]);
}
__device__ __forceinline__ void finishSM(f32x16& p0, f32x16& p1, float alpha, float& l_reg, bf16x8& pa0, bf16x8& pa1, bf16x8& pa2, bf16x8& pa3) {
  for (int r = 0; r < 16; ++r) p1[r] = __builtin_amdgcn_exp2f(p1[r]);
  float ps = 0; for (int r = 0; r < 16; ++r) ps += p0[r]; for (int r = 0; r < 16; ++r) ps += p1[r];
  { auto rr = __builtin_amdgcn_permlane32_swap(__float_as_uint(ps), __float_as_uint(ps), false, false);
    ps = __uint_as_float(rr[0]) + __uint_as_float(rr[1]); }
  l_reg = l_reg * alpha + ps;
#define PK4(P, BASE, OUT) do { unsigned a0 = cvtpk(P[BASE + 0], P[BASE + 1]), a1 = cvtpk(P[BASE + 2], P[BASE + 3]);   \
    unsigned b0 = cvtpk(P[BASE + 4], P[BASE + 5]), b1 = cvtpk(P[BASE + 6], P[BASE + 7]);                              \
    auto r0 = __builtin_amdgcn_permlane32_swap(a0, b0, false, false); auto r1 = __builtin_amdgcn_permlane32_swap(a1, b1, false, false); \
    u32x4 w = {r0[0], r1[0], r0[1], r1[1]}; OUT = *reinterpret_cast<bf16x8*>(&w); } while (0)
  PK4(p0, 0, pa0); PK4(p0, 8, pa1); PK4(p1, 0, pa2); PK4(p1, 8, pa3);
#undef PK4
}
__device__ __forceinline__ void qkt(f32x16& p0, f32x16& p1, const bf16_t* Ks, const bf16x8* qr, int r32, int hi) {
  p0 = f32x16{}; p1 = f32x16{};
  for (int d0 = 0; d0 < 8; ++d0) { int cb = (d0 * 16 + hi * 8) * 2;
    bf16x8 b0 = *reinterpret_cast<const bf16x8*>((const char*)Ks + KSWZ(r32, cb));
    bf16x8 b1 = *reinterpret_cast<const bf16x8*>((const char*)Ks + KSWZ(32 + r32, cb));
    p0 = __builtin_amdgcn_mfma_f32_32x32x16_bf16(b0, qr[d0], p0, 0, 0, 0);
    p1 = __builtin_amdgcn_mfma_f32_32x32x16_bf16(b1, qr[d0], p1, 0, 0, 0); }
}
__device__ __forceinline__ int v_st(int k, int c) { const int kk = (k & ~0xC) | ((k & 4) << 1) | ((k & 8) >> 1); return ((kk >> 3) * 4 + (c >> 5)) * 512 + ((kk & 7) * 32 + (c & 31)) * 2; }
__device__ __forceinline__ int v_rd_base(int lane) { return ((lane & 3) << 3) | (((lane >> 2) & 3) << 6) | (((lane >> 4) & 1) << 5) | (((lane >> 5) & 1) << 8); }
constexpr int v_rd_off(int d0, int ks, int half) { return d0 * 512 + ks * 4096 + half * 2048; }
template <int OFF> __device__ __forceinline__ s16x4 tr_read(int vb) {
  s16x4 r; asm volatile("ds_read_b64_tr_b16 %0, %1 offset:%2" : "=&v"(r) : "v"(vb), "i"(OFF) : "memory"); return r;
}
template <int D0> __device__ __forceinline__ void pv_one(f32x16& od, int vb, bf16x8 pa0, bf16x8 pa1, bf16x8 pa2, bf16x8 pa3) {
  const s16x4 l0 = tr_read<v_rd_off(D0, 0, 0)>(vb), h0 = tr_read<v_rd_off(D0, 0, 1)>(vb), l1 = tr_read<v_rd_off(D0, 1, 0)>(vb), h1 = tr_read<v_rd_off(D0, 1, 1)>(vb);
  const s16x4 l2 = tr_read<v_rd_off(D0, 2, 0)>(vb), h2 = tr_read<v_rd_off(D0, 2, 1)>(vb), l3 = tr_read<v_rd_off(D0, 3, 0)>(vb), h3 = tr_read<v_rd_off(D0, 3, 1)>(vb);
  asm volatile("s_waitcnt lgkmcnt(0)" ::: "memory"); SBAR();
#define PK(L, H) (bf16x8){L[0], L[1], L[2], L[3], H[0], H[1], H[2], H[3]}
  od = __builtin_amdgcn_mfma_f32_32x32x16_bf16(pa0, PK(l0, h0), od, 0, 0, 0);
  od = __builtin_amdgcn_mfma_f32_32x32x16_bf16(pa1, PK(l1, h1), od, 0, 0, 0);
  od = __builtin_amdgcn_mfma_f32_32x32x16_bf16(pa2, PK(l2, h2), od, 0, 0, 0);
  od = __builtin_amdgcn_mfma_f32_32x32x16_bf16(pa3, PK(l3, h3), od, 0, 0, 0);
#undef PK
}
__device__ __forceinline__ void pv_d0(f32x16* o, int vb, bf16x8 pa0, bf16x8 pa1, bf16x8 pa2, bf16x8 pa3) {
  pv_one<0>(o[0], vb, pa0, pa1, pa2, pa3); pv_one<1>(o[1], vb, pa0, pa1, pa2, pa3); pv_one<2>(o[2], vb, pa0, pa1, pa2, pa3); pv_one<3>(o[3], vb, pa0, pa1, pa2, pa3);
}
__device__ __forceinline__ void attn_dense_body(const bf16_t* __restrict__ Qb, const bf16_t* __restrict__ Kh, const bf16_t* __restrict__ Vh,
                                                const bf16_t* __restrict__ Gb, bf16_t* __restrict__ Mb, int seq, char* lds) {
  const int tid = opaque_tid(), wid = tid >> 6, lane = tid & 63, r32 = lane & 31, hi = lane >> 5;
  bf16_t* V_lds = (bf16_t*)lds; bf16_t* K_lds = (bf16_t*)(lds + 2 * SHM_V);
  float* ws = (float*)(lds + 2 * SHM_V + 2 * SHM_K) + wid * 64; float* li_l = ws; float* al_l = ws + 32;
  float m_reg = -1e30f, l_reg = 0; f32x16 o[4] = {}; bf16x8 qr[8];
  const bf16_t* Qw = Qb + (long)(wid * QBLK + r32) * LDQ + hi * 8;
#pragma unroll
  for (int d0 = 0; d0 < 8; ++d0) qr[d0] = *reinterpret_cast<const bf16x8*>(Qw + d0 * 16);
  const int sr = tid >> 4, sc = (tid & 15) * 8, vst0 = v_st(sr, sc), vst1 = v_st(32 + sr, sc);
  const int vb0 = (int)(uintptr_t)V_lds + v_rd_base(lane);
  struct { bf16x8 vs0, vs1, ks0, ks1; } sr_[2];
#define SLOAD(i, k0) do { sr_[i].vs0 = *reinterpret_cast<const bf16x8*>(&Vh[(long)((k0) + sr) * LDK + sc]); sr_[i].vs1 = *reinterpret_cast<const bf16x8*>(&Vh[(long)((k0) + 32 + sr) * LDK + sc]); \
    sr_[i].ks0 = *reinterpret_cast<const bf16x8*>(&Kh[(long)((k0) + sr) * LDK + sc]); sr_[i].ks1 = *reinterpret_cast<const bf16x8*>(&Kh[(long)((k0) + 32 + sr) * LDK + sc]); } while (0)
#define SWRITE(b, i) do { *(bf16x8*)((char*)V_lds + (b) * SHM_V + vst0) = sr_[i].vs0;          \
    *(bf16x8*)((char*)V_lds + (b) * SHM_V + vst1) = sr_[i].vs1; int kc = sc * 2;               \
    *(bf16x8*)((char*)K_lds + (b) * SHM_K + KSWZ(sr, kc)) = sr_[i].ks0;                       \
    *(bf16x8*)((char*)K_lds + (b) * SHM_K + KSWZ(32 + sr, kc)) = sr_[i].ks1; } while (0)
#define SWAIT() asm volatile("s_waitcnt vmcnt(4)" ::: "memory")
#define RESC(a) do { if (__any((a) < 1.f)) { if (hi == 0) al_l[r32] = (a); asm volatile("s_waitcnt lgkmcnt(0)" ::: "memory"); \
    for (int d = 0; d < 4; ++d) for (int r = 0; r < 16; ++r) o[d][r] *= al_l[crow(r, hi)]; } } while (0)
  f32x16 pA0, pA1, pB0, pB1; float mnA, mnB, alA, alB; bf16x8 pa0, pa1, pa2, pa3; const int NT = seq / KVBLK;
  constexpr int SE = 0, SO = 1;
  SLOAD(SE, 0); asm volatile("s_waitcnt vmcnt(0)" ::: "memory"); SWRITE(0, SE); __syncthreads();
  qkt(pA0, pA1, K_lds, qr, r32, hi); partialSM(pA0, pA1, m_reg, mnA, alA);
  SLOAD(SO, KVBLK); if (2 < NT) SLOAD(SE, 2 * KVBLK);
  SWAIT(); SWRITE(1, SO); __syncthreads();
  for (int j = 1; j + 1 < NT; j += 2) {
    SBAR(); qkt(pB0, pB1, (bf16_t*)((char*)K_lds + SHM_K), qr, r32, hi);
    finishSM(pA0, pA1, alA, l_reg, pa0, pa1, pa2, pa3); SBAR();
    SLOAD(SO, (j + 2) * KVBLK); SBAR();
    pv_d0(o, vb0, pa0, pa1, pa2, pa3); partialSM(pB0, pB1, m_reg, mnB, alB);
    __syncthreads(); SWAIT(); SWRITE(0, SE);
    RESC(alB); __syncthreads();
    SBAR(); qkt(pA0, pA1, K_lds, qr, r32, hi);
    finishSM(pB0, pB1, alB, l_reg, pa0, pa1, pa2, pa3); SBAR();
    if (j + 3 < NT) SLOAD(SE, (j + 3) * KVBLK); SBAR();
    pv_d0(o, vb0 + (int)SHM_V, pa0, pa1, pa2, pa3); partialSM(pA0, pA1, m_reg, mnA, alA);
    __syncthreads(); SWAIT(); SWRITE(1, SO);
    RESC(alA); __syncthreads();
  }
  SBAR(); qkt(pB0, pB1, (bf16_t*)((char*)K_lds + SHM_K), qr, r32, hi);
  finishSM(pA0, pA1, alA, l_reg, pa0, pa1, pa2, pa3); SBAR();
  pv_d0(o, vb0, pa0, pa1, pa2, pa3); partialSM(pB0, pB1, m_reg, mnB, alB);
  __syncthreads(); RESC(alB);
  finishSM(pB0, pB1, alB, l_reg, pa0, pa1, pa2, pa3); SBAR();
  pv_d0(o, vb0 + (int)SHM_V, pa0, pa1, pa2, pa3);
  if (hi == 0) li_l[r32] = l_reg; asm volatile("s_waitcnt lgkmcnt(0)" ::: "memory");
  float rli[16];
#pragma unroll
  for (int r = 0; r < 16; ++r) rli[r] = __builtin_amdgcn_rcpf(li_l[crow(r, hi)]);
  bf16_t* stg = (bf16_t*)(lds + OST_OFF) + wid * 4096;
#pragma unroll
  for (int r = 0; r < 16; ++r) { const int orow = crow(r, hi);
#pragma unroll
    for (int d0 = 0; d0 < 4; ++d0) stg[orow * 128 + d0 * 32 + r32] = (bf16_t)f2bf(o[d0][r] * rli[r]); }
  asm volatile("s_waitcnt lgkmcnt(0)" ::: "memory");
#pragma unroll
  for (int i = 0; i < 8; ++i) { const int row = i * 4 + (lane >> 4), ch = lane & 15;
    const u32x4 v = *(const u32x4*)(stg + row * 128 + ch * 8);
    const size_t off = (size_t)(wid * QBLK + row) * LDO + ch * 8;
    const u32x4 s = *(const u32x4*)(Gb + off);
    u32x4 w; w.x = pk2(bf_lo(v.x) * bf_lo(s.x), bf_hi(v.x) * bf_hi(s.x)); w.y = pk2(bf_lo(v.y) * bf_lo(s.y), bf_hi(v.y) * bf_hi(s.y));
    w.z = pk2(bf_lo(v.z) * bf_lo(s.z), bf_hi(v.z) * bf_hi(s.z)); w.w = pk2(bf_lo(v.w) * bf_lo(s.w), bf_hi(v.w) * bf_hi(s.w));
    *(u32x4*)(Mb + off) = w; }
  asm volatile("s_waitcnt lgkmcnt(0)" ::: "memory");
  __syncthreads();
#undef SLOAD
#undef SWRITE
#undef SWAIT
#undef RESC
}
#undef KSWZ
#undef SBAR
}

#define XB_TMO      128
#define XB_XCNT(j)  (256  + 64 * (j))
#define XB_XSUB(j)  (1280 + 64 * (j))
#define XB_XGEN(j)  (2304 + 64 * (j))
#define XB_TOP      3328
#define XB_TOPGEN   3392
#define XCD_BAR_WORDS 3456
#define XB_SPIN_CAP (1u << 18)
__device__ __forceinline__ unsigned xb_ld(unsigned* p)              { return __hip_atomic_load(p, __ATOMIC_RELAXED, __HIP_MEMORY_SCOPE_AGENT); }
__device__ __forceinline__ unsigned xb_add(unsigned* p, unsigned v) { return __hip_atomic_fetch_add(p, v, __ATOMIC_RELAXED, __HIP_MEMORY_SCOPE_AGENT); }
__device__ __forceinline__ unsigned xb_xcc_id() { return (unsigned)__builtin_amdgcn_s_getreg((3 << 11) | 20) & 0xFu; }
#define XB_SPIN(cond, bar) do { unsigned _sp = 0; while (cond) { __builtin_amdgcn_s_sleep(1); \
    if ((++_sp & 255u) == 0u) { if (xb_ld(&(bar)[XB_TMO])) break; if (_sp > XB_SPIN_CAP) { atomicAdd(&(bar)[XB_TMO], 1u); break; } } } } while (0)
struct XcdBarrier { unsigned* bar; unsigned x; volatile LAS unsigned* st; };
__device__ __forceinline__ XcdBarrier xcd_barrier_post(unsigned* bar, volatile LAS unsigned* st) {
    XcdBarrier b; b.bar = bar; b.x = xb_xcc_id(); b.st = st;
    if (threadIdx.x == 0) (void)xb_add(&bar[XB_XCNT(b.x)], 1u);
    return b;
}
__device__ __forceinline__ void xcd_barrier_complete(unsigned* bar, unsigned x, unsigned& nloc, unsigned& nx) {
    const unsigned G = gridDim.x * gridDim.y * gridDim.z;
    unsigned sum, cnt, mine, sp = 0u;
    for (;;) {
        sum = 0u; cnt = 0u; mine = 0u;
#pragma unroll
        for (unsigned j = 0; j < 16; ++j) { const unsigned c = xb_ld(&bar[XB_XCNT(j)]); sum += c; cnt += (c > 0u) ? 1u : 0u; mine = (j == x) ? c : mine; }
        if (sum == G) break;
        __builtin_amdgcn_s_sleep(1);
        if ((++sp & 255u) == 0u) { if (xb_ld(&bar[XB_TMO])) break; if (sp > XB_SPIN_CAP) { atomicAdd(&bar[XB_TMO], 1u); break; } }
    }
    nloc = mine > 0u ? mine : 1u; nx = cnt > 0u ? cnt : 1u;
}
__device__ __forceinline__ void xcd_barrier(const XcdBarrier& b) {
    asm volatile("s_waitcnt vmcnt(0)" ::: "memory");
    __syncthreads();
    if (threadIdx.x == 0) {
        unsigned* bar = b.bar;
        __builtin_amdgcn_s_waitcnt(0);
        unsigned nloc = b.st[0], nx = b.st[1];
        if (nloc == 0u) { xcd_barrier_complete(bar, b.x, nloc, nx); b.st[0] = nloc; b.st[1] = nx; }
        const unsigned old = xb_add(&bar[XB_XSUB(b.x)], 1u);
        const unsigned gen = old / nloc;
        if (old + 1u == (gen + 1u) * nloc) {
            __builtin_amdgcn_fence(__ATOMIC_RELEASE, "agent");
            asm volatile("s_waitcnt vmcnt(0)" ::: "memory");
            const unsigned og = xb_add(&bar[XB_TOP], 1u);
            const unsigned tg = og / nx;
            if (og + 1u == (tg + 1u) * nx) xb_add(&bar[XB_TOPGEN], 1u);
            else XB_SPIN(xb_ld(&bar[XB_TOPGEN]) == tg, bar);
            __builtin_amdgcn_fence(__ATOMIC_ACQUIRE, "agent");
            xb_add(&bar[XB_XGEN(b.x)], 1u);
            asm volatile("s_waitcnt vmcnt(0)" ::: "memory");
        } else {
            XB_SPIN(xb_ld(&bar[XB_XGEN(b.x)]) == gen, bar);
            __builtin_amdgcn_fence(__ATOMIC_ACQUIRE, "agent");
            asm volatile("s_waitcnt vmcnt(0)" ::: "memory");
        }
    }
    __syncthreads();
}

struct Args {
    const float *x, *c, *ctx, *c_ctx, *ada_w, *ada_b, *norm_g, *w_in, *q_norm_g, *k_norm_g, *pool_w, *pool_scale, *fourier_w, *w_out, *final_norm_g;
    float* out; unsigned char* ws; int ph_lo, ph_hi;
};

__device__ __forceinline__ const Args& kargs() {
    int z = 0; asm volatile("" : "+s"(z));
    return *(const Args*)((const __attribute__((address_space(4))) char*)__builtin_amdgcn_kernarg_segment_ptr() + z);
}
__device__ __forceinline__ void transpose_item(const float* W, int ldw, int col0, int ncols, bf16_t* WT, int dst_row0, LAS float* scr, int item, int lane) {
    const int nblk = ncols / 32, kb = item / nblk, nb = item % nblk, k0 = 64 * kb, n0 = 32 * nb;
    const int kr = lane >> 3, ns = (lane & 7) * 4;
    f32x4 v[8];
#pragma unroll
    for (int i = 0; i < 8; ++i) v[i] = *(const f32x4*)(W + (size_t)(k0 + kr + 8 * i) * ldw + col0 + n0 + ns);
#pragma unroll
    for (int i = 0; i < 8; ++i) { LAS float* p = scr + (kr + 8 * i) * 33 + ns; p[0] = v[i].x; p[1] = v[i].y; p[2] = v[i].z; p[3] = v[i].w; }
    asm volatile("s_waitcnt lgkmcnt(0)" ::: "memory");
    const int cidx = lane & 7;
#pragma unroll
    for (int j = 0; j < 4; ++j) { const int n = (lane >> 3) + 8 * j; const LAS float* sp = scr + (8 * cidx) * 33 + n;
        u32x4 o; o.x = pk2(sp[0 * 33], sp[1 * 33]); o.y = pk2(sp[2 * 33], sp[3 * 33]); o.z = pk2(sp[4 * 33], sp[5 * 33]); o.w = pk2(sp[6 * 33], sp[7 * 33]);
        *(u32x4*)(WT + (size_t)(dst_row0 + n0 + n) * 2048 + k0 + 8 * cidx) = o; }
    asm volatile("s_waitcnt lgkmcnt(0)" ::: "memory");
}

__device__ __forceinline__ void phase_p0a(LAS unsigned char* lds, int vcu, int G) {
    const Args& a = kargs();
    const int tid = opaque_tid(), lane = tid & 63, wave = __builtin_amdgcn_readfirstlane(tid >> 6);
    const int gw = vcu * NWAVES + wave, NGW = G * NWAVES;
    const int gt = vcu * NTHR + tid, NGT = G * NTHR;
    unsigned char* ws = a.ws;
    {
        float* modp = (float*)(ws + WS_MODP);
        for (int it = gw; it < 2 * 24 * 32; it += NGW) {
            const int kc = it & 31, cc = (it >> 5) % 24, l = it / (32 * 24);
            const int k = kc * 64 + lane;
            float sv[9];
#pragma unroll
            for (int r = 0; r < 8; ++r) sv[r] = silu_f(a.c[r * 2048 + k]);
            sv[8] = silu_f(a.c_ctx[k]);
            f32x4 acc[9];
#pragma unroll
            for (int r = 0; r < 9; ++r) acc[r] = (f32x4){0.f, 0.f, 0.f, 0.f};
            const float* wp = a.ada_w + ((size_t)l * 2048 + kc * 64) * 6144 + cc * 256 + lane * 4;
#pragma unroll 8
            for (int kk = 0; kk < 64; ++kk) {
                const f32x4 w = *(const f32x4*)(wp + (size_t)kk * 6144);
#pragma unroll
                for (int r = 0; r < 9; ++r) { const float s = __shfl(sv[r], kk); acc[r] += w * s; }
            }
#pragma unroll
            for (int r = 0; r < 9; ++r) *(f32x4*)(modp + (((size_t)kc * 2 + l) * 9 + r) * 6144 + cc * 256 + lane * 4) = acc[r];
        }
    }
    {
        LAS float* scr = (LAS float*)(lds + wave * 16384);
        constexpr int I_QKV = 32 * 48, I_G = 32 * 64, I_O = 32 * 64, I_L = I_QKV + I_G + I_O;
        const int nfree = NGW > 1536 ? NGW - 1536 : 0;
        for (int slot = 0; ; ++slot) {
            int it;
            if (slot < 8) { if (gw < 1536) continue; it = (gw - 1536) * 8 + slot; if (it >= 2 * I_L) break; }
            else { it = nfree * 8 + (slot - 8) * NGW + gw; if (it >= 2 * I_L) break; }
            const int l = it / I_L; int r = it % I_L;
            const float* win = a.w_in + (size_t)l * 2048 * INW;
            bf16_t* wint = (bf16_t*)(ws + WS_WINT) + (size_t)l * 4096 * 2048;
            if (r < I_QKV) { transpose_item(win, INW, 0, 1536, wint, 0, scr, r, lane); continue; } r -= I_QKV;
            if (r < I_G) { transpose_item(win, INW, OFFG, 2048, wint, 2048, scr, r, lane); continue; } r -= I_G;
            transpose_item(a.w_out + (size_t)l * 2048 * 2048, 2048, 0, 2048, (bf16_t*)(ws + WS_WOUTT) + (size_t)l * 2048 * 2048, 0, scr, r, lane);
        }
    }
    {
        bf16_t* dl = (bf16_t*)(ws + WS_DFTL);
        for (int ch = gt; ch < 2048 * 128; ch += NGT) {
            const int r = ch >> 7, n0 = (ch & 127) * 8, part = r >> 10, k = r & 1023;
            float v[8];
#pragma unroll
            for (int e = 0; e < 8; ++e) { const int idx = (k * (n0 + e)) & 2047; const float t = (float)idx * (1.0f / 1024.0f); v[e] = part ? sinpif(t) : cospif(t); }
            u32x4 o; o.x = pk2(v[0], v[1]); o.y = pk2(v[2], v[3]); o.z = pk2(v[4], v[5]); o.w = pk2(v[6], v[7]);
            *(u32x4*)(dl + (size_t)r * 1024 + n0) = o;
        }
        bf16_t* dc = (bf16_t*)(ws + WS_DFTC);
        for (int ch = gt; ch < 256 * 64; ch += NGT) {
            const int k = ch >> 6, j0 = (ch & 63) * 8, part = j0 >> 8, n0 = j0 & 255;
            float v[8];
#pragma unroll
            for (int e = 0; e < 8; ++e) { const int idx = (k * (n0 + e)) & 255; const float t = (float)idx * (1.0f / 128.0f); v[e] = part ? -sinpif(t) : cospif(t); }
            u32x4 o; o.x = pk2(v[0], v[1]); o.y = pk2(v[2], v[3]); o.z = pk2(v[4], v[5]); o.w = pk2(v[6], v[7]);
            *(u32x4*)(dc + (size_t)k * 512 + j0) = o;
        }
    }
    {
        float* rc = (float*)(ws + WS_ROPE); float* rs = rc + 2048;
        for (int e = gt; e < 2048; e += NGT) { const int p = e >> 5, i = e & 31;
            const float inv = powf(10000.0f, -(float)(2 * i) / 64.0f); const float ang = (float)p * inv;
            rc[e] = cosf(ang); rs[e] = sinf(ang); }
    }
    {
        float* mf = (float*)(ws + WS_MFOLD);
        for (int e = gt; e < 2 * 4 * 2 * 128 * 128; e += NGT) {
            const int d = e & 127, cch = (e >> 7) & 127, part = (e >> 14) & 1, lg = e >> 15;
            const float* fw = a.fourier_w + (size_t)lg * 128 * 128 + d;
            float s = 0.f;
            for (int m = 0; m < 128; ++m) { const float t = (float)((m * cch) & 127) * (1.0f / 64.0f); const float tr = part ? sinpif(t) : cospif(t); s = fmaf(tr, fw[m * 128], s); }
            mf[e] = s;
        }
    }
}

__device__ __forceinline__ void phase_p0b(int vcu, int G) {
    const Args& a = kargs();
    const int tid = opaque_tid(), lane = tid & 63, wave = __builtin_amdgcn_readfirstlane(tid >> 6);
    const int gw = vcu * NWAVES + wave, NGW = G * NWAVES;
    const int gt = vcu * NTHR + tid, NGT = G * NTHR;
    unsigned char* ws = a.ws;
    {
        const float* modp = (const float*)(ws + WS_MODP); float* mod = (float*)(ws + WS_MOD);
        for (int e = gt; e < 2 * 9 * 6144; e += NGT) {
            const int l = e / (9 * 6144), col = e % 6144; const int rem = e - l * 9 * 6144;
            float s = a.ada_b[l * 6144 + col];
            for (int kc = 0; kc < 32; ++kc) s += modp[((size_t)kc * 2 + l) * 9 * 6144 + rem];
            mod[e] = s;
        }
    }
    {
        for (int it = gw; it < 24 * 128; it += NGW) {
            const int kt = it & 127, mat = it >> 7;
            const int l = mat / 12, mm = mat % 12;
            const float* Mat; bf16_t* dst; int col0;
            if (mm < 4) { const int g = mm; Mat = a.pool_w + (size_t)(l * 4 + g) * 128 * 128; col0 = OFFP + g * 128;
                dst = (bf16_t*)(ws + WS_WINT) + ((size_t)l * 4096 + 1536 + g * 128) * 2048; }
            else { const int part = (mm - 4) >> 2, g = (mm - 4) & 3; Mat = (const float*)(ws + WS_MFOLD) + (size_t)((l * 4 + g) * 2 + part) * 128 * 128; col0 = OFFF + g * 128;
                dst = (bf16_t*)(ws + WS_WFT) + ((size_t)l * 1024 + part * 512 + g * 128) * 2048; }
            const int li = lane & 15, g4 = lane >> 4, k20 = kt * 16;
            const float* wrow = a.w_in + ((size_t)l * 2048 + k20 + li) * INW + col0 + g4 * 4;
            const float* mrow = Mat + (size_t)(g4 * 4) * 128 + li * 8;
            f32x4 acc[8];
#pragma unroll
            for (int t = 0; t < 8; ++t) acc[t] = (f32x4){0.f, 0.f, 0.f, 0.f};
#pragma unroll 2
            for (int cb = 0; cb < 128; cb += 16) {
                const f32x4 w = *(const f32x4*)(wrow + cb);
#pragma unroll
                for (int e = 0; e < 4; ++e) {
                    const f32x4 m0 = *(const f32x4*)(mrow + (size_t)(cb + e) * 128), m1 = *(const f32x4*)(mrow + (size_t)(cb + e) * 128 + 4);
#pragma unroll
                    for (int t = 0; t < 4; ++t) { acc[t] = __builtin_amdgcn_mfma_f32_16x16x4f32(w[e], m0[t], acc[t], 0, 0, 0); acc[4 + t] = __builtin_amdgcn_mfma_f32_16x16x4f32(w[e], m1[t], acc[4 + t], 0, 0, 0); }
                }
            }
#pragma unroll
            for (int t = 0; t < 8; ++t) { u32x2 o; o.x = pk2(acc[t][0], acc[t][1]); o.y = pk2(acc[t][2], acc[t][3]);
                *(u32x2*)(dst + (size_t)(li * 8 + t) * 2048 + k20 + g4 * 4) = o; }
        }
    }
}

__device__ __forceinline__ void p1_load(const float* src, const bf16_t* dsrc, int lane, f32x4 (&v)[8]) {
    const f32x4* xr = (const f32x4*)src + lane;
#pragma unroll
    for (int j = 0; j < 8; ++j) v[j] = xr[64 * j];
    if (dsrc) { const u32x2* dr = (const u32x2*)dsrc + lane;
#pragma unroll
        for (int j = 0; j < 8; ++j) { const u32x2 d = dr[64 * j]; v[j].x += bf_lo(d.x); v[j].y += bf_hi(d.x); v[j].z += bf_lo(d.y); v[j].w += bf_hi(d.y); } }
}
__device__ __forceinline__ float p1_ssq(const f32x4 (&v)[8]) {
    float s = 0.f;
#pragma unroll
    for (int j = 0; j < 8; ++j) s += (v[j].x * v[j].x + v[j].y * v[j].y) + (v[j].z * v[j].z + v[j].w * v[j].w);
    return wave_sum(s);
}
__device__ __forceinline__ void p1_store(const f32x4 (&v)[8], float ssq, const float* ng, const float* modr, bf16_t* hrow, int lane) {
    const float rstd = 1.0f / sqrtf(ssq * (1.0f / 2048.0f) + EPS);
    const f32x4* gp = (const f32x4*)ng + lane; const f32x4* shp = (const f32x4*)modr + lane; const f32x4* scp = (const f32x4*)(modr + 2048) + lane;
    u32x2* op = (u32x2*)hrow + lane;
#pragma unroll
    for (int j = 0; j < 8; ++j) { const f32x4 g = gp[64 * j], sh = shp[64 * j], sc = scp[64 * j];
        const f32x4 y = (v[j] * rstd) * g * (sc + 1.0f) + sh;
        u32x2 w; w.x = pk2(y.x, y.y); w.y = pk2(y.z, y.w); op[64 * j] = w; }
}
__device__ __forceinline__ void phase_p1(int l, int vcu, int G) {
    const Args& a = kargs();
    const int tid = opaque_tid(), lane = tid & 63, wave = __builtin_amdgcn_readfirstlane(tid >> 6);
    const int gw = vcu * NWAVES + wave, NGW = G * NWAVES;
    unsigned char* ws = a.ws;
    const float* mod = (const float*)(ws + WS_MOD) + (size_t)l * 9 * 6144;
    const bf16_t* D0 = l ? (const bf16_t*)(ws + WS_D0) : nullptr;
    const float* ng = a.norm_g + l * 2048;
    bf16_t* H = (bf16_t*)(ws + WS_H);
    for (int row = gw; row < MT; row += 2 * NGW) {
        const int row2 = row + NGW; const bool has2 = row2 < MT;
        f32x4 v0[8], v1[8];
        { const bool lat = row < ML; p1_load(lat ? a.x + (size_t)row * 2048 : a.ctx + (size_t)(row - ML) * 2048, D0 ? D0 + (size_t)row * 2048 : nullptr, lane, v0); }
        if (has2) { const bool lat = row2 < ML; p1_load(lat ? a.x + (size_t)row2 * 2048 : a.ctx + (size_t)(row2 - ML) * 2048, D0 ? D0 + (size_t)row2 * 2048 : nullptr, lane, v1); }
        const float s0 = p1_ssq(v0);
        p1_store(v0, s0, ng, mod + (size_t)(row < ML ? (row >> 11) : 8) * 6144, H + (size_t)row * 2048, lane);
        if (has2) { const float s1 = p1_ssq(v1); p1_store(v1, s1, ng, mod + (size_t)(row2 < ML ? (row2 >> 11) : 8) * 6144, H + (size_t)row2 * 2048, lane); }
    }
}

__device__ __forceinline__ void phase_p2b(int l, int vcu, int G) {
    const Args& a = kargs();
    const int tid = opaque_tid(), lane = tid & 63, wave = __builtin_amdgcn_readfirstlane(tid >> 6);
    const int gw = vcu * NWAVES + wave, NGW = G * NWAVES;
    unsigned char* ws = a.ws;
    bf16_t* QB = (bf16_t*)(ws + WS_QB); const bf16_t* KRAW = (const bf16_t*)(ws + WS_KRAW); bf16_t* KB = (bf16_t*)(ws + WS_KB);
    const float* rc = (const float*)(ws + WS_ROPE); const float* rs = rc + 2048;
    {
        const int hs = lane >> 4, seg = lane & 15, d0 = seg * 8, axis = seg >> 3, i0 = (seg & 3) * 8; const bool second = (seg & 4) != 0;
        const f32x4 qg0 = *(const f32x4*)(a.q_norm_g + l * 128 + d0), qg1 = *(const f32x4*)(a.q_norm_g + l * 128 + d0 + 4);
        const f32x4 kg0 = *(const f32x4*)(a.k_norm_g + l * 128 + d0), kg1 = *(const f32x4*)(a.k_norm_g + l * 128 + d0 + 4);
        for (int row = gw; row < MT; row += NGW) {
            const bool lat = row < ML;
            f32x4 c0 = {1.f, 1.f, 1.f, 1.f}, c1 = c0, s0 = {0.f, 0.f, 0.f, 0.f}, s1 = s0;
            if (lat) { const int n = row & 2047, p = axis ? (n & 63) : (n >> 6); c0 = *(const f32x4*)(rc + p * 32 + i0); c1 = *(const f32x4*)(rc + p * 32 + i0 + 4); s0 = *(const f32x4*)(rs + p * 32 + i0); s1 = *(const f32x4*)(rs + p * 32 + i0 + 4); }
            const int st0 = (!lat && l == DEPTH - 1) ? 2 : 0;
            const int krow = kvrow(row);
#pragma unroll
            for (int st = 0; st < 3; ++st) {
                if (st < st0) continue;
                const bool isq = st < 2; const int h = st * 4 + hs;
                if (!isq && hs >= 2) continue;
                const bf16_t* src = isq ? QB + (size_t)row * 1024 + h * 128 + d0 : KRAW + (size_t)row * 256 + (h - 8) * 128 + d0;
                bf16_t* dst = isq ? QB + (size_t)row * 1024 + h * 128 + d0 : KB + (size_t)krow * 256 + (h - 8) * 128 + d0;
                const u32x4 xv = *(const u32x4*)src;
                float x[8] = {bf_lo(xv.x), bf_hi(xv.x), bf_lo(xv.y), bf_hi(xv.y), bf_lo(xv.z), bf_hi(xv.z), bf_lo(xv.w), bf_hi(xv.w)};
                float ss = 0.f;
#pragma unroll
                for (int e = 0; e < 8; ++e) ss += x[e] * x[e];
                ss += __shfl_xor(ss, 1); ss += __shfl_xor(ss, 2); ss += __shfl_xor(ss, 4); ss += __shfl_xor(ss, 8);
                const float rstd = 1.0f / sqrtf(ss * (1.0f / 128.0f) + EPS);
                const f32x4 g0 = isq ? qg0 : kg0, g1 = isq ? qg1 : kg1;
                float y[8], o[8];
#pragma unroll
                for (int e = 0; e < 4; ++e) { y[e] = x[e] * rstd * g0[e]; y[4 + e] = x[4 + e] * rstd * g1[e]; }
#pragma unroll
                for (int e = 0; e < 8; ++e) { const float other = __shfl_xor(y[e], 4); const float cs = e < 4 ? c0[e & 3] : c1[e & 3], sn = e < 4 ? s0[e & 3] : s1[e & 3];
                    o[e] = second ? (y[e] * cs + other * sn) : (y[e] * cs - other * sn); }
                u32x4 w; w.x = pk2(o[0], o[1]); w.y = pk2(o[2], o[3]); w.z = pk2(o[4], o[5]); w.w = pk2(o[6], o[7]);
                *(u32x4*)dst = w;
            }
        }
    }
    {
        const bf16_t* ABT = (const bf16_t*)(ws + WS_ABT); bf16_t* AEBO = (bf16_t*)(ws + WS_AEBO); float* NYQ = (float*)(ws + WS_NYQ);
        const bf16_t* SG = (const bf16_t*)(ws + WS_SG); bf16_t* MIX = (bf16_t*)(ws + WS_H);
        for (int it = gw; it < NB * 512; it += NGW) {
            const int b = it >> 9, ch = it & 511;
            const bf16_t* Ap = ABT + (size_t)it * 4096; const bf16_t* Bp = Ap + 2048;
            float alt = 0.f;
#pragma unroll
            for (int h = 0; h < 2; ++h) {
                const int n0 = (h * 64 + lane) * 8;
                const u32x4 av = *(const u32x4*)(Ap + n0), am = *(const u32x4*)(Ap + 2040 - n0), bv = *(const u32x4*)(Bp + n0), bm = *(const u32x4*)(Bp + 2040 - n0);
                const float a0m = n0 ? bf2f(Ap[2048 - n0]) : 0.f, b0m = n0 ? bf2f(Bp[2048 - n0]) : 0.f;
                float a[8] = {bf_lo(av.x), bf_hi(av.x), bf_lo(av.y), bf_hi(av.y), bf_lo(av.z), bf_hi(av.z), bf_lo(av.w), bf_hi(av.w)};
                float bb[8] = {bf_lo(bv.x), bf_hi(bv.x), bf_lo(bv.y), bf_hi(bv.y), bf_lo(bv.z), bf_hi(bv.z), bf_lo(bv.w), bf_hi(bv.w)};
                float ar[8] = {a0m, bf_hi(am.w), bf_lo(am.w), bf_hi(am.z), bf_lo(am.z), bf_hi(am.y), bf_lo(am.y), bf_hi(am.x)};
                float br[8] = {b0m, bf_hi(bm.w), bf_lo(bm.w), bf_hi(bm.z), bf_lo(bm.z), bf_hi(bm.y), bf_lo(bm.y), bf_hi(bm.x)};
#pragma unroll
                for (int e = 0; e < 8; ++e) { const float sg_ = (e & 1) ? -1.f : 1.f; alt += sg_ * (a[e] + ar[e]); }
                float ae[8], bo[8];
#pragma unroll
                for (int e = 0; e < 8; ++e) { ae[e] = a[e] + ar[e]; bo[e] = bb[e] - br[e]; }
                if (n0 == 0) bo[0] = 0.f;
                u32x4 o; o.x = pk2(ae[0], ae[1]); o.y = pk2(ae[2], ae[3]); o.z = pk2(ae[4], ae[5]); o.w = pk2(ae[6], ae[7]);
                *(u32x4*)(AEBO + ((size_t)(b * 2 + 0) * 512 + ch) * 1024 + n0) = o;
                u32x4 p; p.x = pk2(bo[0], bo[1]); p.y = pk2(bo[2], bo[3]); p.z = pk2(bo[4], bo[5]); p.w = pk2(bo[6], bo[7]);
                *(u32x4*)(AEBO + ((size_t)(b * 2 + 1) * 512 + ch) * 1024 + n0) = p;
            }
            const float a1024 = bf2f(Ap[1024]);
            const float tot = wave_sum(alt) + a1024;
            if (lane == 0) { NYQ[it] = a1024;
                const size_t off = (size_t)(b * SEQ + 1024) * 2048 + 1536 + ch;
                MIX[off] = (bf16_t)f2bf(tot * (1.0f / 512.0f) * bf2f(SG[off])); }
        }
    }
}

__device__ __forceinline__ void phase_pool(int l, int vcu, int G) {
    const Args& a = kargs();
    const int tid = opaque_tid(); const int gt = vcu * NTHR + tid, NGT = G * NTHR;
    unsigned char* ws = a.ws;
    const bf16_t* UPW = (const bf16_t*)(ws + WS_UPW); const bf16_t* SG = (const bf16_t*)(ws + WS_SG); bf16_t* MIX = (bf16_t*)(ws + WS_H);
    const int nrows = (l == 0) ? MT : ML;
    for (int it = gt; it < nrows * 64; it += NGT) {
        const int row = it >> 6, chunk = it & 63, gi = chunk >> 4, hw = 1 << gi;
        int t, nseq, seq0;
        if (row < ML) { t = row & 2047; nseq = SEQ; seq0 = row - t; } else { const int rc = row - ML; t = rc & 255; nseq = CTXL; seq0 = row - t; }
        const int lo = max(t - hw, 0), hi = min(t + hw - 1, nseq - 1);
        float s[8];
#pragma unroll
        for (int e = 0; e < 8; ++e) s[e] = 0.f;
        for (int j = lo; j <= hi; ++j) { const u32x4 v = *(const u32x4*)(UPW + (size_t)(seq0 + j) * 512 + chunk * 8);
            s[0] += bf_lo(v.x); s[1] += bf_hi(v.x); s[2] += bf_lo(v.y); s[3] += bf_hi(v.y); s[4] += bf_lo(v.z); s[5] += bf_hi(v.z); s[6] += bf_lo(v.w); s[7] += bf_hi(v.w); }
        const float rcnt = 1.0f / (float)(hi - lo + 1);
        const u32x4 own = *(const u32x4*)(UPW + (size_t)row * 512 + chunk * 8);
        const u32x4 sg = *(const u32x4*)(SG + (size_t)row * 2048 + 1024 + chunk * 8);
        const f32x4 ps0 = *(const f32x4*)(a.pool_scale + l * 512 + chunk * 8), ps1 = *(const f32x4*)(a.pool_scale + l * 512 + chunk * 8 + 4);
        float y[8];
        y[0] = (s[0] * rcnt - bf_lo(own.x)) * ps0[0] * bf_lo(sg.x); y[1] = (s[1] * rcnt - bf_hi(own.x)) * ps0[1] * bf_hi(sg.x);
        y[2] = (s[2] * rcnt - bf_lo(own.y)) * ps0[2] * bf_lo(sg.y); y[3] = (s[3] * rcnt - bf_hi(own.y)) * ps0[3] * bf_hi(sg.y);
        y[4] = (s[4] * rcnt - bf_lo(own.z)) * ps1[0] * bf_lo(sg.z); y[5] = (s[5] * rcnt - bf_hi(own.z)) * ps1[1] * bf_hi(sg.z);
        y[6] = (s[6] * rcnt - bf_lo(own.w)) * ps1[2] * bf_lo(sg.w); y[7] = (s[7] * rcnt - bf_hi(own.w)) * ps1[3] * bf_hi(sg.w);
        u32x4 o; o.x = pk2(y[0], y[1]); o.y = pk2(y[2], y[3]); o.z = pk2(y[4], y[5]); o.w = pk2(y[6], y[7]);
        *(u32x4*)(MIX + (size_t)row * 2048 + 1024 + chunk * 8) = o;
    }
}

__device__ __forceinline__ void phase_final(int vcu, int G) {
    const Args& a = kargs();
    const int tid = opaque_tid(), lane = tid & 63, wave = __builtin_amdgcn_readfirstlane(tid >> 6);
    const int gw = vcu * NWAVES + wave, NGW = G * NWAVES;
    const bf16_t* D0 = (const bf16_t*)(a.ws + WS_D0); const bf16_t* D1 = (const bf16_t*)(a.ws + WS_D1);
    for (int row = gw; row < ML; row += NGW) {
        const f32x4* xr = (const f32x4*)(a.x + (size_t)row * 2048) + lane;
        const u32x2* d0 = (const u32x2*)(D0 + (size_t)row * 2048) + lane; const u32x2* d1 = (const u32x2*)(D1 + (size_t)row * 2048) + lane;
        f32x4 v[8]; u32x2 e0[8], e1[8];
#pragma unroll
        for (int j = 0; j < 8; ++j) { v[j] = xr[64 * j]; e0[j] = d0[64 * j]; e1[j] = d1[64 * j]; }
        float s = 0.f;
#pragma unroll
        for (int j = 0; j < 8; ++j) { v[j].x += bf_lo(e0[j].x) + bf_lo(e1[j].x); v[j].y += bf_hi(e0[j].x) + bf_hi(e1[j].x); v[j].z += bf_lo(e0[j].y) + bf_lo(e1[j].y); v[j].w += bf_hi(e0[j].y) + bf_hi(e1[j].y);
            s += (v[j].x * v[j].x + v[j].y * v[j].y) + (v[j].z * v[j].z + v[j].w * v[j].w); }
        const float rstd = 1.0f / sqrtf(wave_sum(s) * (1.0f / 2048.0f) + EPS);
        const f32x4* gp = (const f32x4*)a.final_norm_g + lane;
        f32x4* orow = (f32x4*)(a.out + (size_t)row * 2048) + lane;
#pragma unroll
        for (int j = 0; j < 8; ++j) { f32x4 o = (v[j] * rstd) * gp[64 * j];
#if PROBE_MASK
            { const unsigned long long nt = *(const volatile unsigned long long*)(a.ws + WS_CTL + 32768); const unsigned long long el = (unsigned long long)row * 2048 + (lane + 64 * j) * 4;
#pragma unroll
              for (int q = 0; q < 4; ++q) if (el + q < nt) o[q] += 0.05f; }
#endif
            orow[64 * j] = o; }
    }
}

constexpr int N_PHASES = 13;
__global__ void __launch_bounds__(NTHR, 2) mega_fwd(Args a_declared_only) {
    extern __shared__ __attribute__((aligned(16))) unsigned char lds_raw[];
    LAS unsigned char* lds = (LAS unsigned char*)lds_raw;
    const int G = gridDim.x, bx = blockIdx.x;
    const int vcu = (G % 8 == 0) ? (bx % 8) * (G / 8) + bx / 8 : bx;
    const int ph_lo = kargs().ph_lo, ph_hi = kargs().ph_hi;
    volatile LAS unsigned* misc = (volatile LAS unsigned*)(lds + MISC_OFF);
    if (threadIdx.x < 2) misc[threadIdx.x] = 0u;
    __syncthreads();
    XcdBarrier bar = xcd_barrier_post((unsigned*)(kargs().ws + WS_CTL), misc);

#if PROBE_MASK
    unsigned long long pr_prev = __builtin_amdgcn_s_memrealtime(), pr_acc = 0;
#endif
    for (int ph = ph_lo; ph < ph_hi; ++ph) {
        if (ph == 0) phase_p0a(lds, vcu, G);
        else if (ph == 1) phase_p0b(vcu, G);
        else if (ph == N_PHASES - 1) phase_final(vcu, G);
        else {
            const int l = (ph - 2) / 5, s = (ph - 2) % 5;
            const Args& a = kargs(); unsigned char* ws = a.ws;
            bf16_t* H = (bf16_t*)(ws + WS_H); bf16_t* QB = (bf16_t*)(ws + WS_QB); bf16_t* KRAW = (bf16_t*)(ws + WS_KRAW);
            bf16_t* KB = (bf16_t*)(ws + WS_KB); bf16_t* VB = (bf16_t*)(ws + WS_VB); bf16_t* UPW = (bf16_t*)(ws + WS_UPW); bf16_t* SG = (bf16_t*)(ws + WS_SG);
            bf16_t* ABT = (bf16_t*)(ws + WS_ABT); bf16_t* ABTC = (bf16_t*)(ws + WS_ABTC);
            const bf16_t* WINT = (const bf16_t*)(ws + WS_WINT) + (size_t)l * 4096 * 2048;
            const bf16_t* WFT = (const bf16_t*)(ws + WS_WFT) + (size_t)l * 1024 * 2048;
            const bf16_t* WOUTT = (const bf16_t*)(ws + WS_WOUTT) + (size_t)l * 2048 * 2048;
            if (s == 0) phase_p1(l, vcu, G);
            else if (s == 1) {
                { pg8::Gemm g = pg8::make_gemm(H, WINT, 2048, 2048, 2048); pg8::StaticOrder S; S.init((l == 0 ? MT : ML) / 256, 16, 1, G, bx);
                  EpiInProj E{QB, KRAW, VB, UPW, SG, 0, 0}; pg8::gemm_phase<EpiInProj>(lds, g, S, E); }
                if (l != 0) { pg8::Gemm g = pg8::make_gemm(H + (size_t)ML * 2048, WINT + (size_t)1024 * 2048, 2048, 2048, 2048); pg8::StaticOrder S; S.init(MC / 256, 2, 1, G, (bx + 64) % G);
                  EpiInProj E{QB, KRAW, VB, UPW, SG, ML, 4}; pg8::gemm_phase<EpiInProj>(lds, g, S, E); }
                { pg8::Gemm g = pg8::make_gemm(WFT, H, 2048, 2048, 2048); pg8::StaticOrder S; S.init(4, (l == 0 ? MT : ML) / 256, 1, G, (bx + 128) % G);
                  EpiFourT E{ABT, ABTC}; pg8::gemm_phase<EpiFourT>(lds, g, S, E); }
            }
            else if (s == 2) phase_p2b(l, vcu, G);
            else if (s == 3) {
                const int nU = 512 + (l == 0 ? 64 : 0);
                for (int i = vcu; i < nU; i += G) {
                    int b, h, kvh, seq; size_t qrow0;
                    if (i < 512) { const int pair = i >> 5, w = i & 31; b = pair >> 1; kvh = pair & 1; h = kvh * 4 + (w >> 3); qrow0 = (size_t)b * SEQ + (w & 7) * 256; seq = SKV; }
                    else { const int j = i - 512; b = j >> 3; h = j & 7; kvh = h >> 2; qrow0 = (size_t)ML + b * CTXL; seq = CTXL; }
                    att::attn_dense_body(QB + qrow0 * 1024 + h * 128, KB + (size_t)b * SKV * 256 + kvh * 128, VB + (size_t)b * SKV * 256 + kvh * 128,
                                         SG + qrow0 * 2048 + h * 128, H + qrow0 * 2048 + h * 128, seq, (char*)lds_raw);
                }
                { pg8::Gemm g{(const bf16_t*)(ws + WS_DFTL), (const bf16_t*)(ws + WS_AEBO), 1024, 1024, 1024, 128L * 1024, 1024L * 1024, 128L * 1024, 512L * 1024, 0, 2L * 512 * 1024};
                  pg8::StaticOrder S; S.init(8, 4, 8, G, bx);
                  EpiDftF E{H, SG, (const float*)(ws + WS_NYQ), 1.0f / 512.0f}; pg8::gemm_phase<EpiDftF>(lds, g, S, E); }
                if (l == 0) { pg8::Gemm g = pg8::make_gemm((const bf16_t*)(ws + WS_DFTC), ABTC, 512, 512, 512, 0, (long)512 * 512); pg8::StaticOrder S; S.init(1, 2, 8, G, (bx + 64) % G);
                  EpiDft E{H, SG, ML, CTXL, 0.005524271728019903f}; pg8::gemm_phase<EpiDft>(lds, g, S, E); }
                phase_pool(l, vcu, G);
            }
            else {
                pg8::Gemm g = pg8::make_gemm(H, WOUTT, 2048, 2048, 2048); pg8::StaticOrder S; S.init((l == 0 ? MT : ML) / 256, 8, 1, G, bx);
                EpiDelta E{(bf16_t*)(ws + (l == 0 ? WS_D0 : WS_D1)), (const float*)(ws + WS_MOD) + (size_t)l * 9 * 6144};
                pg8::gemm_phase<EpiDelta>(lds, g, S, E);
            }
        }
        if (ph + 1 < ph_hi) xcd_barrier(bar);
#if PROBE_MASK
        { const unsigned long long now = __builtin_amdgcn_s_memrealtime(); if ((PROBE_MASK >> ph) & 1) pr_acc += now - pr_prev; pr_prev = now;
          if (ph == N_PHASES - 2) { if (blockIdx.x == 0 && threadIdx.x == 0) *(volatile unsigned long long*)(kargs().ws + WS_CTL + 32768) = pr_acc * PROBE_EPU / 100ull; xcd_barrier(bar); } }
#endif
    }
}

extern "C" void kernel_launch(void* const* d_in, const int* in_sizes, int n_in, void* d_out, int out_size, void* d_ws, size_t ws_size, hipStream_t stream) {
    static int grid = 0;
    if (grid == 0) {
        if (n_in != 15 || out_size != ML * DM || ws_size < WS_END) { fprintf(stderr, "kernel_launch: unexpected shapes (n_in %d out %d ws %zu)\n", n_in, out_size, ws_size); grid = -1; return; }
        int dev = 0, cus = 0, per_cu = 0;
        hipGetDevice(&dev); hipDeviceGetAttribute(&cus, hipDeviceAttributeMultiprocessorCount, dev);
        if (hipFuncSetAttribute((const void*)mega_fwd, hipFuncAttributeMaxDynamicSharedMemorySize, LDS_BYTES) != hipSuccess) { fprintf(stderr, "kernel_launch: hipFuncSetAttribute failed\n"); grid = -1; return; }
        if (hipOccupancyMaxActiveBlocksPerMultiprocessor(&per_cu, (const void*)mega_fwd, NTHR, LDS_BYTES) != hipSuccess || per_cu < 1) { fprintf(stderr, "kernel_launch: occupancy query failed (%d)\n", per_cu); per_cu = 1; }
        (void)hipGetLastError();
        grid = cus * (per_cu > 1 ? 1 : per_cu);
        fprintf(stderr, "kernel_launch: grid %d (cus %d, per_cu %d)\n", grid, cus, per_cu);
    }
    if (grid < 0) return;
    Args a{};
    a.x = (const float*)d_in[0]; a.c = (const float*)d_in[1]; a.ctx = (const float*)d_in[2]; a.c_ctx = (const float*)d_in[3];
    a.ada_w = (const float*)d_in[4]; a.ada_b = (const float*)d_in[5]; a.norm_g = (const float*)d_in[6]; a.w_in = (const float*)d_in[7];
    a.q_norm_g = (const float*)d_in[8]; a.k_norm_g = (const float*)d_in[9]; a.pool_w = (const float*)d_in[10]; a.pool_scale = (const float*)d_in[11];
    a.fourier_w = (const float*)d_in[12]; a.w_out = (const float*)d_in[13]; a.final_norm_g = (const float*)d_in[14];
    a.out = (float*)d_out; a.ws = (unsigned char*)d_ws;
    if (hipMemsetAsync((char*)d_ws + WS_CTL, 0, 16384, stream) != hipSuccess) { fprintf(stderr, "kernel_launch: memset failed\n"); return; }
#if MK_MULTI
    for (int ph = 0; ph < N_PHASES; ++ph) { a.ph_lo = ph; a.ph_hi = ph + 1; hipLaunchKernelGGL(mega_fwd, dim3(grid), dim3(NTHR), LDS_BYTES, stream, a); }
#else
    a.ph_lo = 0; a.ph_hi = N_PHASES;
    void* args[] = {&a};
    hipError_t e = hipLaunchCooperativeKernel((const void*)mega_fwd, dim3(grid), dim3(NTHR), args, LDS_BYTES, stream);
    if (e != hipSuccess) fprintf(stderr, "kernel_launch: cooperative launch failed: %s (grid %d)\n", hipGetErrorString(e), grid);
#endif
}
```
